# Optimizing an MI355X kernel written in HIP

```python
import math
import jax, jax.numpy as jnp
from jax import lax
import numpy as np

D_MODEL = 2048
BATCH = 16
SEQ = 2048
DEPTH = 1

P_DIM = 256
GRID_W = 64
MIX_WIDTH = D_MODEL
MLSTM_WIDTH = MIX_WIDTH // 2
ATTN_WIDTH = MIX_WIDTH - MLSTM_WIDTH
MLSTM_HEADS = 8
MLSTM_DV = MLSTM_WIDTH // MLSTM_HEADS
MLSTM_DQK = MLSTM_DV // 2
MLSTM_CHUNK = 64
CONV_W = 5
ATTN_HEAD_DIM = 128
ATTN_Q_HEADS = ATTN_WIDTH // ATTN_HEAD_DIM
ATTN_KV_HEADS = 2
ROPE_FREQS = ATTN_HEAD_DIM // 4
ROPE_THETA = 10000.0
Q_BLOCK = 128
N_EXPERTS = 16
EXPERT_FF = D_MODEL // 2
CAPACITY_FACTOR = 2
NORM_EPS = 1e-6
ALPHA = (2.0 * DEPTH) ** 0.25
BETA = (8.0 * DEPTH) ** -0.25

MQ_COLS = MLSTM_HEADS * MLSTM_DQK
MK_COLS = MLSTM_HEADS * MLSTM_DQK
MV_COLS = MLSTM_WIDTH
MO_COLS = MLSTM_WIDTH
MG_COLS = 2 * 2 * MLSTM_HEADS
AQ_COLS = ATTN_Q_HEADS * ATTN_HEAD_DIM
AK_COLS = ATTN_KV_HEADS * ATTN_HEAD_DIM
AV_COLS = ATTN_KV_HEADS * ATTN_HEAD_DIM
IN_SIZES = (MQ_COLS, MK_COLS, MV_COLS, MO_COLS, MG_COLS, AQ_COLS, AK_COLS, AV_COLS)
IN_COLS = MQ_COLS + MK_COLS + MV_COLS + MO_COLS + MG_COLS + AQ_COLS + AK_COLS + AV_COLS

kernel_name = "hybrid_mlstm_axialgqa_ecmoe_deepnorm"


def _split_points():
    pts, acc = [], 0
    for s in IN_SIZES[:-1]:
        acc += s
        pts.append(acc)
    return pts


def _layer_norm(x, g, b):
    xf = x.astype(jnp.float32)
    mu = jnp.mean(xf, axis=-1, keepdims=True)
    var = jnp.mean(jnp.square(xf - mu), axis=-1, keepdims=True)
    return ((xf - mu) * lax.rsqrt(var + NORM_EPS) * g + b).astype(x.dtype)


def _rms_norm(x, g):
    xf = x.astype(jnp.float32)
    return (xf * lax.rsqrt(jnp.mean(xf * xf, axis=-1, keepdims=True) + NORM_EPS) * g).astype(x.dtype)


def _centred_depthwise_conv(x, w):
    c = x.shape[-1]
    return lax.conv_general_dilated(
        x, w[:, None, :], window_strides=(1,), padding=[(CONV_W // 2, CONV_W // 2)],
        dimension_numbers=("NWC", "WIO", "NWC"), feature_group_count=c)


def _mlstm_chunkwise(q, k, v, log_i, log_f):
    B, H, S, _ = q.shape
    dqk, dv = q.shape[-1], v.shape[-1]
    L = MLSTM_CHUNK
    nc = S // L

    def to_chunks(a):
        return jnp.moveaxis(a.reshape(B, H, nc, L, *a.shape[3:]), 2, 0)

    xs = (to_chunks(q), to_chunks(k), to_chunks(v), to_chunks(log_i), to_chunks(log_f))
    lower = jnp.tril(jnp.ones((L, L), dtype=bool))

    def step(carry, inp):
        C, n, m = carry
        qb, kb, vb, li, lf = inp
        b = jnp.cumsum(lf, axis=-1)
        d = jnp.where(lower, b[..., :, None] - b[..., None, :] + li[..., None, :], -jnp.inf)
        inter = b + m[..., None]
        m_t = jnp.maximum(inter, jnp.max(d, axis=-1))
        w_intra = jnp.exp(d - m_t[..., None])
        w_inter = jnp.exp(inter - m_t)
        s = jnp.einsum("bhtd,bhsd->bhts", qb, kb) * w_intra
        num = (jnp.einsum("bhts,bhsv->bhtv", s, vb)
               + w_inter[..., None] * jnp.einsum("bhtd,bhdv->bhtv", qb, C))
        den = jnp.sum(s, axis=-1) + w_inter * jnp.einsum("bhtd,bhd->bht", qb, n)
        h = num / jnp.maximum(jnp.abs(den), jnp.exp(-m_t))[..., None]
        b_last = b[..., -1]
        g = b_last[..., None] - b + li
        m_new = jnp.maximum(b_last + m, jnp.max(g, axis=-1))
        decay = jnp.exp(b_last + m - m_new)
        wk = jnp.exp(g - m_new[..., None])
        C_new = decay[..., None, None] * C + jnp.einsum("bhs,bhsd,bhsv->bhdv", wk, kb, vb)
        n_new = decay[..., None] * n + jnp.einsum("bhs,bhsd->bhd", wk, kb)
        return (C_new, n_new, m_new), h

    init = (jnp.zeros((B, H, dqk, dv), jnp.float32), jnp.zeros((B, H, dqk), jnp.float32),
            jnp.zeros((B, H), jnp.float32))
    _, hs = lax.scan(step, init, xs)
    return jnp.moveaxis(hs, 0, 2).reshape(B, H, S, dv)


def _mlstm_mixer(q, k, v, o, gates, conv_w, b_i, b_f, g_head):
    B, S, _ = q.shape
    qk = jax.nn.silu(_centred_depthwise_conv(jnp.concatenate([q, k], axis=-1), conv_w))
    q, k = jnp.split(qk, 2, axis=-1)

    def heads(a, d):
        return a.reshape(B, S, MLSTM_HEADS, d).transpose(0, 2, 1, 3).astype(jnp.float32)

    qh = heads(q, MLSTM_DQK) * (MLSTM_DQK ** -0.5)
    kh = heads(k, MLSTM_DQK)
    vh = heads(v, MLSTM_DV)
    g = gates.astype(jnp.float32).reshape(B, S, 2, 2, MLSTM_HEADS)
    log_i = (g[:, :, :, 0] + b_i).transpose(2, 0, 3, 1)
    log_f = jax.nn.log_sigmoid(g[:, :, :, 1] + b_f).transpose(2, 0, 3, 1)
    h_fwd = _mlstm_chunkwise(qh, kh, vh, log_i[0], log_f[0])
    rev = lambda a: jnp.flip(a, axis=2)
    h_bwd = rev(_mlstm_chunkwise(rev(qh), rev(kh), rev(vh), rev(log_i[1]), rev(log_f[1])))
    h = _rms_norm((h_fwd + h_bwd).transpose(0, 2, 1, 3), g_head)
    return (jax.nn.sigmoid(o.astype(jnp.float32)) * h.reshape(B, S, MLSTM_WIDTH)).astype(o.dtype)


def _axial_rope_tables(S):
    rows = S // GRID_W
    row_idx = jnp.broadcast_to(jnp.arange(rows, dtype=jnp.float32)[:, None], (rows, GRID_W)).reshape(-1)
    col_idx = jnp.broadcast_to(jnp.arange(GRID_W, dtype=jnp.float32)[None, :], (rows, GRID_W)).reshape(-1)
    inv_freq = ROPE_THETA ** (-jnp.arange(ROPE_FREQS, dtype=jnp.float32) / ROPE_FREQS)
    ang = jnp.stack([row_idx[:, None] * inv_freq, col_idx[:, None] * inv_freq], axis=1)
    return jnp.cos(ang), jnp.sin(ang)


def _apply_axial_rope(x, cos, sin):
    xr = x.astype(jnp.float32).reshape(*x.shape[:-1], 2, 2, ROPE_FREQS)
    x1, x2 = xr[..., 0, :], xr[..., 1, :]
    out = jnp.stack([x1 * cos - x2 * sin, x2 * cos + x1 * sin], axis=-2)
    return out.reshape(x.shape)


def _axial_gqa(q, k, v, g_q, g_k):
    B, S, _ = q.shape
    G = ATTN_Q_HEADS // ATTN_KV_HEADS
    d = ATTN_HEAD_DIM
    qh = q.reshape(B, S, ATTN_KV_HEADS, G, d).transpose(0, 2, 3, 1, 4)
    kh = k.reshape(B, S, ATTN_KV_HEADS, d).transpose(0, 2, 1, 3)
    vh = v.reshape(B, S, ATTN_KV_HEADS, d).transpose(0, 2, 1, 3)
    cos, sin = _axial_rope_tables(S)
    qh = _apply_axial_rope(_rms_norm(qh, g_q), cos, sin) * (d ** -0.5)
    kh = _apply_axial_rope(_rms_norm(kh, g_k), cos, sin)
    nb = S // Q_BLOCK
    qb = qh.reshape(B, ATTN_KV_HEADS, G, nb, Q_BLOCK, d).transpose(3, 0, 1, 2, 4, 5)

    def block(q_blk):
        s = jnp.einsum("bkgqd,bksd->bkgqs", q_blk, kh)
        pr = jax.nn.softmax(s.astype(jnp.float32), axis=-1)
        return jnp.einsum("bkgqs,bksd->bkgqd", pr.astype(vh.dtype), vh)

    ob = lax.map(block, qb)
    return ob.transpose(1, 0, 4, 2, 3, 5).reshape(B, S, ATTN_WIDTH).astype(v.dtype)


def _expert_choice_moe(x, w_router, w_gate, w_up, w_down):
    B, S, D = x.shape
    cap = CAPACITY_FACTOR * S // N_EXPERTS
    affinity = jax.nn.softmax(jnp.einsum("bsd,de->bse", x, w_router).astype(jnp.float32), axis=-1)
    gate, idx = lax.top_k(affinity.transpose(0, 2, 1), cap)
    xs = jax.vmap(lambda xb, ib: xb[ib])(x, idx)
    hid = jax.nn.silu(jnp.einsum("becd,edf->becf", xs, w_gate)) * jnp.einsum("becd,edf->becf", xs, w_up)
    y = jnp.einsum("becf,efd->becd", hid, w_down) * gate[..., None].astype(x.dtype)
    return jax.vmap(lambda yb, ib: jnp.zeros((S, D), yb.dtype).at[ib.reshape(-1)].add(yb.reshape(-1, D)))(y, idx)


def setup_inputs(seed: int = 0) -> dict:
    key = jax.random.key(seed)
    ks = jax.random.split(key, 24)
    f32 = jnp.float32
    nrm = lambda k, shape, s: jax.random.normal(k, shape, f32) * s
    v_scale = jnp.concatenate([
        jnp.ones((MQ_COLS + MK_COLS,), f32), jnp.full((MV_COLS,), BETA, f32),
        jnp.ones((MO_COLS + MG_COLS + AQ_COLS + AK_COLS,), f32), jnp.full((AV_COLS,), BETA, f32)])
    return {
        "x": jax.random.normal(ks[0], (BATCH, SEQ, D_MODEL), f32),
        "p": jax.random.normal(ks[1], (DEPTH, BATCH, SEQ, P_DIM), f32),
        "w_in": nrm(ks[2], (DEPTH, D_MODEL, IN_COLS), D_MODEL ** -0.5) * v_scale,
        "conv_w": nrm(ks[3], (DEPTH, CONV_W, MQ_COLS + MK_COLS), CONV_W ** -0.5),
        "b_igate": nrm(ks[4], (DEPTH, 2, MLSTM_HEADS), 0.1),
        "b_fgate": jnp.broadcast_to(jnp.linspace(3.0, 6.0, MLSTM_HEADS, dtype=f32), (DEPTH, 2, MLSTM_HEADS))
                   + nrm(ks[5], (DEPTH, 2, MLSTM_HEADS), 0.1),
        "g_mlstm": 1.0 + nrm(ks[6], (DEPTH, MLSTM_HEADS, MLSTM_DV), 0.05),
        "g_q": 1.0 + nrm(ks[7], (DEPTH, ATTN_HEAD_DIM), 0.05),
        "g_k": 1.0 + nrm(ks[8], (DEPTH, ATTN_HEAD_DIM), 0.05),
        "w_out": nrm(ks[9], (DEPTH, MIX_WIDTH, D_MODEL), BETA * MIX_WIDTH ** -0.5),
        "ln1_g": 1.0 + nrm(ks[10], (DEPTH, D_MODEL), 0.05),
        "ln1_b": nrm(ks[11], (DEPTH, D_MODEL), 0.02),
        "w_router": nrm(ks[12], (DEPTH, D_MODEL, N_EXPERTS), D_MODEL ** -0.5),
        "w_gate": nrm(ks[13], (DEPTH, N_EXPERTS, D_MODEL, EXPERT_FF), D_MODEL ** -0.5),
        "w_up": nrm(ks[14], (DEPTH, N_EXPERTS, D_MODEL, EXPERT_FF), D_MODEL ** -0.5),
        "w_down": nrm(ks[15], (DEPTH, N_EXPERTS, EXPERT_FF, D_MODEL), BETA * EXPERT_FF ** -0.5),
        "w_pl_proj": nrm(ks[16], (DEPTH, P_DIM, D_MODEL), BETA * P_DIM ** -0.5),
        "w_pl_gate": nrm(ks[17], (DEPTH, D_MODEL, D_MODEL), D_MODEL ** -0.5),
        "b_pl_gate": nrm(ks[18], (DEPTH, D_MODEL), 0.02),
        "ln2_g": 1.0 + nrm(ks[19], (DEPTH, D_MODEL), 0.05),
        "ln2_b": nrm(ks[20], (DEPTH, D_MODEL), 0.02),
    }


def reference(x, p, w_in, conv_w, b_igate, b_fgate, g_mlstm, g_q, g_k, w_out, ln1_g, ln1_b,
              w_router, w_gate, w_up, w_down, w_pl_proj, w_pl_gate, b_pl_gate, ln2_g, ln2_b):
    splits = _split_points()
    for i in range(DEPTH):
        proj = jnp.einsum("bsd,dc->bsc", x, w_in[i])
        mq, mk, mv, mo, mg, aq, ak, av = jnp.split(proj, splits, axis=-1)
        h_mlstm = _mlstm_mixer(mq, mk, mv, mo, mg, conv_w[i], b_igate[i], b_fgate[i], g_mlstm[i])
        h_attn = _axial_gqa(aq, ak, av, g_q[i], g_k[i])
        mix = jnp.einsum("bsc,cd->bsd", jnp.concatenate([h_mlstm, h_attn], axis=-1), w_out[i])
        x = _layer_norm(ALPHA * x + mix, ln1_g[i], ln1_b[i])
        moe = _expert_choice_moe(x, w_router[i], w_gate[i], w_up[i], w_down[i])
        pl_gate = jax.nn.sigmoid(jnp.einsum("bsd,de->bse", x, w_pl_gate[i]) + b_pl_gate[i])
        pl = pl_gate * jnp.einsum("bsp,pd->bsd", p[i], w_pl_proj[i])
        x = _layer_norm(ALPHA * x + moe + pl, ln2_g[i], ln2_b[i])
    return x
```

```cpp
#include <hip/hip_runtime.h>
#include <hip/hip_cooperative_groups.h>
#include <cstdio>
#include <cstdint>
namespace cg = cooperative_groups;

#ifndef MK_ONE_LAUNCH
#define MK_ONE_LAUNCH 1
#endif

#define LAS __attribute__((address_space(3)))
typedef unsigned short bf16_t;
typedef short bf16x8 __attribute__((ext_vector_type(8)));
typedef short s16x4 __attribute__((ext_vector_type(4)));
typedef float f32x4 __attribute__((ext_vector_type(4)));
typedef float f32x16 __attribute__((ext_vector_type(16)));
typedef unsigned u32x4 __attribute__((ext_vector_type(4)));
typedef unsigned u32x2 __attribute__((ext_vector_type(2)));
typedef int v8i_t __attribute__((ext_vector_type(8)));

constexpr int NB = 16, SEQ = 2048, DM = 2048, NTOK = NB * SEQ;
constexpr int PJ_LD = 4608;
constexpr int C_AQ = 0, C_AK = 1024, C_AV = 1280, C_MQ = 1536, C_MK = 2048, C_MV = 2560, C_MO = 3584;
constexpr int WIN_ROWS = 4864;
constexpr int NEXP = 16, CAP = 256, FF = 1024, NSLOT = NB * NEXP * CAP;
constexpr float ALPHA = 1.189207115002721f;
constexpr float NORM_EPS = 1e-6f;

constexpr size_t MiB = 1u << 20;
constexpr size_t WS_CTL = 0, WS_ROPE = 1 * MiB, WS_WRT = 1 * MiB + 65536;
constexpr size_t WS_WIN = 2 * MiB, WS_WOUT = 22 * MiB, WS_WPG = 30 * MiB, WS_WPP = 38 * MiB, WS_WGU = 40 * MiB, WS_WDN = 168 * MiB;
constexpr size_t WS_PB = 232 * MiB, WS_GATES = 248 * MiB, WS_AFF = 252 * MiB, WS_IDX = 254 * MiB, WS_GATEV = 254 * MiB + 512 * 1024, WS_SLOT = 255 * MiB;
constexpr size_t WS_RA = 258 * MiB;
constexpr size_t WS_RB = 546 * MiB;
constexpr size_t WS_RC = 674 * MiB;
constexpr size_t WS_RE = 802 * MiB;
constexpr size_t WS_STATS = WS_RE + 64 * MiB;
constexpr size_t WS_END = 930 * MiB;

constexpr int STAGE_BYTES = 131072;
constexpr int LDS_GIDX = STAGE_BYTES;
constexpr int LDS_MISC = LDS_GIDX + 8192;
constexpr int LDS_BYTES = 147456;

__device__ __forceinline__ unsigned f2bf(float f) { unsigned u = __builtin_bit_cast(unsigned, f); return (u + 0x7fffu + ((u >> 16) & 1u)) >> 16; }
__device__ __forceinline__ unsigned pk2(float lo, float hi) { return f2bf(lo) | (f2bf(hi) << 16); }
typedef __bf16 bf16x2v_ __attribute__((ext_vector_type(2)));
typedef float f32x2v_ __attribute__((ext_vector_type(2)));
__device__ __forceinline__ unsigned cvt_pk_bf16(float lo, float hi) { f32x2v_ f = {lo, hi}; bf16x2v_ h = __builtin_convertvector(f, bf16x2v_); return __builtin_bit_cast(unsigned, h); }
__device__ __forceinline__ unsigned pk4_fp8(float a, float b, float c, float d) { int w = 0; w = __builtin_amdgcn_cvt_pk_fp8_f32(a, b, w, false); w = __builtin_amdgcn_cvt_pk_fp8_f32(c, d, w, true); return (unsigned)w; }
__device__ __forceinline__ float bf_lo(unsigned w) { return __uint_as_float(w << 16); }
__device__ __forceinline__ float bf_hi(unsigned w) { return __uint_as_float(w & 0xffff0000u); }
__device__ __forceinline__ float bf2f(bf16_t b) { return __uint_as_float(((unsigned)b) << 16); }
__device__ __forceinline__ float sigmoidf_(float x) { return __builtin_amdgcn_rcpf(1.0f + __expf(-x)); }
__device__ __forceinline__ float siluf_(float x) { return x * __builtin_amdgcn_rcpf(1.0f + __expf(-x)); }
#define WS_DPP(v, ctrl) ((v) + __builtin_bit_cast(float, __builtin_amdgcn_update_dpp(0, __builtin_bit_cast(int, (v)), (ctrl), 0xf, 0xf, true)))
#define WS_DPPV(v, ctrl) __builtin_bit_cast(float, __builtin_amdgcn_update_dpp(0, __builtin_bit_cast(int, (v)), (ctrl), 0xf, 0xf, true))
__device__ __forceinline__ float row_sum16(float v) { v = WS_DPP(v, 0xB1); v = WS_DPP(v, 0x4E); v = WS_DPP(v, 0x141); v = WS_DPP(v, 0x140); return v; }
__device__ __forceinline__ float row_max16(float v) { v = fmaxf(v, WS_DPPV(v, 0xB1)); v = fmaxf(v, WS_DPPV(v, 0x4E)); v = fmaxf(v, WS_DPPV(v, 0x141)); v = fmaxf(v, WS_DPPV(v, 0x140)); return v; }
__device__ __forceinline__ float lane_xor4(float v, int lane) { const float up = WS_DPPV(v, 0x104), dn = WS_DPPV(v, 0x114); return (lane & 4) ? dn : up; }
__device__ __forceinline__ float wave_sum(float v) {
    v = WS_DPP(v, 0xB1); v = WS_DPP(v, 0x4E); v = WS_DPP(v, 0x141); v = WS_DPP(v, 0x140);
    const int vi = __builtin_bit_cast(int, v);
    const float r0 = __builtin_bit_cast(float, __builtin_amdgcn_readlane(vi, 0)), r1 = __builtin_bit_cast(float, __builtin_amdgcn_readlane(vi, 16));
    const float r2 = __builtin_bit_cast(float, __builtin_amdgcn_readlane(vi, 32)), r3 = __builtin_bit_cast(float, __builtin_amdgcn_readlane(vi, 48));
    return (r0 + r1) + (r2 + r3);
}
#define LDS_WAIT() asm volatile("s_waitcnt lgkmcnt(0)" ::: "memory")
#define VM_WAIT() asm volatile("s_waitcnt vmcnt(0)" ::: "memory")

struct Params {
    const float* in[21];
    float* out;
    unsigned char* ws;
    int ph_lo, ph_hi;
};
enum { I_X = 0, I_P, I_WIN, I_CONVW, I_BI, I_BF, I_GM, I_GQ, I_GK, I_WOUT, I_LN1G, I_LN1B, I_WR, I_WG, I_WU, I_WD, I_WPP, I_WPG, I_BPG, I_LN2G, I_LN2B };

namespace pg8 {
constexpr int BM = 256, BK = 64, HALF = 128, HTB = HALF * BK * 2, NXCD = 8, WGM = 8;
__device__ __forceinline__ int lds_byte(int r, int c) { const int st = (r >> 4) * 2 + (c >> 5), rr = r & 15, cc = c & 31, ob = rr * 64 + cc * 2; return st * 1024 + (ob ^ (((ob >> 9) & 1) << 5)); }
__device__ __forceinline__ void stage_rc(int b, int& R, int& C) { const int st = b / 1024, sb = b % 1024, swz = sb ^ (((sb >> 9) & 1) << 5); R = (st >> 1) * 16 + swz / 64; C = (st & 1) * 32 + (swz % 64) / 2; }
__device__ __forceinline__ int perm32(int rho) { const int n = rho >> 4, i = rho & 15; return 8 * (i >> 2) + 4 * n + (i & 3); }

struct Unit { int pm, pn; };
struct frag2_t { bf16x8 lo, hi; };

struct StaticOrder {
    int nM, nN, nwg, G, c;
    __device__ void init(int M, int N, int G_, int c_) { nM = M / BM; nN = N / BM; nwg = nM * nN; G = G_; c = c_; }
    __device__ bool next(int i, Unit& u) const {
        const long L = (long)i * G + c; if (L >= nwg) return false;
        int wgid = (int)L; { const int q = nwg / NXCD, r = nwg % NXCD, xcd = wgid % NXCD, off = wgid / NXCD; wgid = (xcd < r ? xcd * (q + 1) : r * (q + 1) + (xcd - r) * q) + off; }
        const int nig = WGM * nN, gid = wgid / nig, fm = gid * WGM, gsz = (nM - fm) < WGM ? (nM - fm) : WGM;
        u.pm = fm + ((wgid % nig) % gsz); u.pn = (wgid % nig) / gsz; return true;
    }
    __device__ __forceinline__ bool slot(int) const { return false; }
};
struct MoeOrder {
    int G, c;
    __device__ bool next(int i, Unit& u) const {
        if (G == 256) { if (i >= 8) return false; const int x = c & 7, w = c >> 3, e = 2 * i + (x >> 2), b = 4 * (x & 3) + (w >> 3), j = w & 7; u.pm = b * 16 + e; u.pn = e * 8 + j; return true; }
        const long L = (long)i * G + c; if (L >= 2048) return false;
        u.pm = (int)(L >> 3); u.pn = (u.pm & 15) * 8 + (int)(L & 7); return true;
    }
    __device__ __forceinline__ bool slot(int) const { return false; }
};

template <class T, class = void> struct epi_preload { static constexpr bool value = false; };
template <class T> struct epi_preload<T, decltype((void)T::PRELOAD)> { static constexpr bool value = T::PRELOAD; };
template <class Epi, class Sched, bool GATHER, bool F8 = false>
__device__ __forceinline__ void gemm_phase(LAS unsigned char* lds, const void* A, const void* Bt, const int K, const Sched& S, const Epi& E, const int* rowidx) {
    int tid_ = threadIdx.x; asm volatile("" : "+v"(tid_));
    const int tid = tid_, wid = __builtin_amdgcn_readfirstlane(tid >> 6), lane = tid & 63, wr = wid >> 2, wc = wid & 3, fr = lane & 15, fq = lane >> 4;
    const int nt = F8 ? K / 128 : K / BK;
    const int RP = F8 ? K : 2 * K;
    unsigned voffB[1];
    { int R, C; stage_rc(tid * 16, R, C); const int Rb = Epi::PERM ? ((R & ~31) + perm32(R & 31)) : R; voffB[0] = (unsigned)(Rb * RP + C * 2); }
    const size_t kstep = (size_t)(BK * 2);
    const size_t hstep = (size_t)HALF * RP;
    const size_t pstep = (size_t)64 * RP;
    const size_t tstep = 2 * hstep;
    const unsigned ldsw = (unsigned)wid * 1024u;
    const int aoff = lds_byte(wr * 64 + fr, fq * 8), boff = lds_byte(wc * 32 + fr, fq * 8);
    const int aoff8a = lds_byte(wr * 64 + fr, fq * 16) + (fq & 1) * 16, boff8a = lds_byte(wc * 32 + fr, fq * 16) + (fq & 1) * 16, aoff8b = aoff8a ^ 16, boff8b = boff8a ^ 16;
    LAS int* lidx = (LAS int*)(lds + LDS_GIDX);
    Unit cur, nxt; int ui = 0;
    if (!S.next(0, cur)) return;
    if (GATHER) {
        Unit u;
        for (int i = 0; i < 8 && S.next(i, u); ++i) if (tid < 256) lidx[i * 256 + tid] = rowidx[u.pm * 256 + tid];
        LDS_WAIT(); __syncthreads();
    }
#define PG8_ROWOFF(uidx, unit, h, i) ((unsigned)((GATHER ? lidx[(uidx) * 256 + (h) * 128 + rp_[i]] : ((unit).pm * 256 + (h) * 128 + rp_[i])) * RP + cp_[i] * 2))
#define PG8_RC_DECL() int rp_[2], cp_[2]; { int t_ = tid; asm volatile("" : "+v"(t_)); _Pragma("unroll") for (int i_ = 0; i_ < 2; ++i_) stage_rc(t_ * 16 + i_ * 8192, rp_[i_], cp_[i_]); }
#define PG8_SA(b, h) (((b) * 2 + (h)) * HTB)
#define PG8_SB(b, h) ((4 + (b) * 2 + (h)) * HTB)
#define PG8_STAGE(bufoff, gbase, voff) do { _Pragma("unroll") for (int _i = 0; _i < 2; ++_i) \
        __builtin_amdgcn_global_load_lds((const unsigned*)((const char*)(gbase) + (size_t)_i * pstep + (voff)[0]), (LAS unsigned*)(lds + (bufoff) + ldsw + _i * 8192), 16, 0, 0); } while (0)
#define PG8_STAGE_A(bufoff, gbase, voff) do { if constexpr (GATHER) { _Pragma("unroll") for (int _i = 0; _i < 2; ++_i) \
        __builtin_amdgcn_global_load_lds((const unsigned*)((const char*)(gbase) + (voff)[_i]), (LAS unsigned*)(lds + (bufoff) + ldsw + _i * 8192), 16, 0, 0); } else PG8_STAGE(bufoff, gbase, voff); } while (0)
#define PG8_LDA(dst, b, h) do { if constexpr (F8) { _Pragma("unroll") for (int m = 0; m < 4; ++m) { dst[m][0] = *(const LAS bf16x8*)(lds + PG8_SA(b, h) + aoff8a + m * 2048); dst[m][1] = *(const LAS bf16x8*)(lds + PG8_SA(b, h) + aoff8b + m * 2048); } } \
        else { _Pragma("unroll") for (int m = 0; m < 4; ++m) _Pragma("unroll") for (int k = 0; k < 2; ++k) dst[m][k] = *(const LAS bf16x8*)(lds + PG8_SA(b, h) + aoff + m * 2048 + k * 1024); } } while (0)
#define PG8_LDB(dst, b, h) do { if constexpr (F8) { _Pragma("unroll") for (int n = 0; n < 2; ++n) { dst[n][0] = *(const LAS bf16x8*)(lds + PG8_SB(b, h) + boff8a + n * 2048); dst[n][1] = *(const LAS bf16x8*)(lds + PG8_SB(b, h) + boff8b + n * 2048); } } \
        else { _Pragma("unroll") for (int n = 0; n < 2; ++n) _Pragma("unroll") for (int k = 0; k < 2; ++k) dst[n][k] = *(const LAS bf16x8*)(lds + PG8_SB(b, h) + boff + n * 2048 + k * 1024); } } while (0)
#define PG8_F8FRAG(X) __builtin_bit_cast(v8i_t, (frag2_t){X[0], X[1]})
#define PG8_MMA(ai, bj, At, Bt_) do { __builtin_amdgcn_s_setprio(1); if constexpr (F8) { _Pragma("unroll") for (int m = 0; m < 4; ++m) _Pragma("unroll") for (int n = 0; n < 2; ++n) \
            acc[ai][bj][m][n] = __builtin_amdgcn_mfma_scale_f32_16x16x128_f8f6f4(PG8_F8FRAG(Bt_[n]), PG8_F8FRAG(At[m]), acc[ai][bj][m][n], 0, 0, 0, 0, 0, 0); } \
        else { _Pragma("unroll") for (int m = 0; m < 4; ++m) _Pragma("unroll") for (int n = 0; n < 2; ++n) _Pragma("unroll") for (int k = 0; k < 2; ++k) \
        acc[ai][bj][m][n] = __builtin_amdgcn_mfma_f32_16x16x32_bf16(Bt_[n][k], At[m][k], acc[ai][bj][m][n], 0, 0, 0); } __builtin_amdgcn_s_setprio(0); } while (0)
#define PG8_WAIT_V(n) asm volatile("s_waitcnt vmcnt(" #n ")" ::: "memory")
#define PG8_WAIT_L(n) asm volatile("s_waitcnt lgkmcnt(" #n ")" ::: "memory")
#define PG8_BAR __builtin_amdgcn_s_barrier()
#define PG8_SCHED __builtin_amdgcn_sched_barrier(0)
    f32x4 acc[2][2][4][2];
#pragma unroll
    for (int a = 0; a < 2; ++a)
#pragma unroll
        for (int b = 0; b < 2; ++b)
#pragma unroll
            for (int m = 0; m < 4; ++m)
#pragma unroll
                for (int n = 0; n < 2; ++n) acc[a][b][m][n] = (f32x4){0.f, 0.f, 0.f, 0.f};
    bf16x8 At[4][2], B0[2][2], B1[2][2];
    unsigned offA0[2], offA1[2];
    { PG8_RC_DECL();
#pragma unroll
      for (int i = 0; i < (GATHER ? 2 : 1); ++i) { offA0[i] = PG8_ROWOFF(0, cur, 0, i); offA1[i] = PG8_ROWOFF(0, cur, 1, i); } }
    const char* Ab = (const char*)A;
    const char* cB = (const char*)Bt + (size_t)cur.pn * tstep;
    PG8_STAGE(PG8_SB(0, 0), cB, voffB); PG8_STAGE(PG8_SB(0, 1), cB + hstep, voffB); PG8_STAGE_A(PG8_SA(0, 0), Ab, offA0); PG8_STAGE_A(PG8_SA(0, 1), Ab, offA1);
    if (wr == 1) PG8_BAR;
    PG8_WAIT_V(2); PG8_BAR;
    PG8_STAGE(PG8_SB(1, 0), cB + kstep, voffB); PG8_STAGE_A(PG8_SA(1, 0), Ab + kstep, offA0); PG8_STAGE(PG8_SB(1, 1), cB + hstep + kstep, voffB);
    PG8_WAIT_V(6); PG8_BAR;
    float egv[2][4];
    int nst = 0;
    for (;;) {
        const bool has_next = S.next(ui + 1, nxt);
        const char* nB = has_next ? (const char*)Bt + (size_t)nxt.pn * tstep : cB;
#pragma unroll 1
        for (int t = 0; t < nt; t += 2) {
            const bool last = (t == nt - 2);
            const char* a1 = Ab + (size_t)(t + 1) * kstep;
            const char* a2 = last ? Ab : Ab + (size_t)(t + 2) * kstep; const char* b2 = last ? nB : cB + (size_t)(t + 2) * kstep;
            const char* a3 = a2 + kstep; const char* b3 = b2 + kstep;
            if constexpr (epi_preload<Epi>::value) { if (last) E.preload(cur, wr, fr, egv); }
            PG8_LDB(B0, 0, 0); PG8_LDB(B1, 0, 1); PG8_SCHED; PG8_LDA(At, 0, 0); PG8_STAGE_A(PG8_SA(1, 1), a1, offA1);
            if (last && has_next) {
                PG8_RC_DECL();
#pragma unroll
                for (int i = 0; i < (GATHER ? 2 : 1); ++i) { offA0[i] = PG8_ROWOFF(ui + 1, nxt, 0, i); offA1[i] = PG8_ROWOFF(ui + 1, nxt, 1, i); }
            }
            if (epi_preload<Epi>::value && last) PG8_WAIT_V(16); else if (t == 0 && nst == 16) PG8_WAIT_V(24); else if (t == 0 && nst == 8) PG8_WAIT_V(16); else PG8_WAIT_V(8);
            PG8_WAIT_L(0); PG8_BAR; PG8_MMA(0, 0, At, B0); PG8_MMA(0, 1, At, B1); PG8_BAR; PG8_SCHED;
            PG8_LDA(At, 0, 1); PG8_STAGE(PG8_SB(0, 0), b2, voffB); PG8_STAGE(PG8_SB(0, 1), b2 + hstep, voffB); PG8_STAGE_A(PG8_SA(0, 0), a2, offA0);
            if (epi_preload<Epi>::value && last) PG8_WAIT_V(16); else if (t == 0 && nst == 16) PG8_WAIT_V(24); else if (t == 0 && nst == 8) PG8_WAIT_V(16); else PG8_WAIT_V(8);
            PG8_WAIT_L(0); PG8_BAR; PG8_MMA(1, 0, At, B0); PG8_MMA(1, 1, At, B1); PG8_BAR; PG8_SCHED;
            PG8_LDB(B0, 1, 0); PG8_LDB(B1, 1, 1); PG8_SCHED; PG8_LDA(At, 1, 0); PG8_STAGE_A(PG8_SA(0, 1), a2, offA1);
            PG8_WAIT_V(8); PG8_WAIT_L(0); PG8_BAR; PG8_MMA(0, 0, At, B0); PG8_MMA(0, 1, At, B1); PG8_BAR; PG8_SCHED;
            PG8_LDA(At, 1, 1); PG8_STAGE(PG8_SB(1, 0), b3, voffB); PG8_STAGE(PG8_SB(1, 1), b3 + hstep, voffB); PG8_STAGE_A(PG8_SA(1, 0), a3, offA0);
            PG8_WAIT_V(8); PG8_WAIT_L(0); PG8_BAR; PG8_MMA(1, 0, At, B0); PG8_MMA(1, 1, At, B1); PG8_BAR; PG8_SCHED;
        }
        if (wr == 0) PG8_BAR;
        if constexpr (epi_preload<Epi>::value) E(acc, cur, wr, wc, fr, fq, egv); else E(acc, cur, wr, wc, fr, fq);
        nst = E.nstores(cur, wc);
        if (S.slot(ui)) nst = 0;
        if (!has_next) break;
#pragma unroll
        for (int a = 0; a < 2; ++a)
#pragma unroll
            for (int b = 0; b < 2; ++b)
#pragma unroll
                for (int m = 0; m < 4; ++m)
#pragma unroll
                    for (int n = 0; n < 2; ++n) acc[a][b][m][n] = (f32x4){0.f, 0.f, 0.f, 0.f};
        cur = nxt; cB = nB; ++ui;
        if (wr == 1) PG8_BAR;
    }
    PG8_WAIT_V(0);
    PG8_BAR;
#undef PG8_ROWOFF
#undef PG8_RC_DECL
#undef PG8_SA
#undef PG8_SB
#undef PG8_STAGE
#undef PG8_STAGE_A
#undef PG8_LDA
#undef PG8_LDB
#undef PG8_MMA
#undef PG8_F8FRAG
#undef PG8_WAIT_V
#undef PG8_WAIT_L
#undef PG8_BAR
#undef PG8_SCHED
}

#define EPI_LOOP_AM _Pragma("unroll") for (int ai = 0; ai < 2; ++ai) _Pragma("unroll") for (int m = 0; m < 4; ++m)
typedef const f32x4 (&AccRef)[2][2][4][2];

struct EpiProj {
    static constexpr bool PERM = true;
    bf16_t* proj; float* gates;
    __device__ __forceinline__ int nstores(const Unit& u, int wc) const { return (u.pn < 18 || wc == 0) ? 16 : 0; }
    __device__ __forceinline__ void operator()(AccRef acc, const Unit& u, int wr, int wc, int fr, int fq) const {
        const int row0 = u.pm * BM + wr * 64 + fr;
        if (u.pn < 18) {
            const int col0 = u.pn * BM + wc * 32 + 8 * fq;
            EPI_LOOP_AM { bf16_t* rowp = proj + (size_t)(row0 + ai * HALF + m * 16) * PJ_LD + col0;
#pragma unroll
                for (int bj = 0; bj < 2; ++bj) { const f32x4 v0 = acc[ai][bj][m][0], v1 = acc[ai][bj][m][1];
                    u32x4 w; w.x = cvt_pk_bf16(v0[0], v0[1]); w.y = cvt_pk_bf16(v0[2], v0[3]); w.z = cvt_pk_bf16(v1[0], v1[1]); w.w = cvt_pk_bf16(v1[2], v1[3]);
                    __builtin_nontemporal_store(w, (u32x4*)(rowp + bj * HALF)); } }
        } else if (wc == 0) {
            EPI_LOOP_AM { float* rowp = gates + (size_t)(row0 + ai * HALF + m * 16) * 32 + 8 * fq;
                *(f32x4*)(rowp) = acc[ai][0][m][0]; *(f32x4*)(rowp + 4) = acc[ai][0][m][1]; }
        }
    }
};
struct EpiOut {
    static constexpr bool PERM = true;
    const bf16_t* xb; bf16_t* y;
    __device__ __forceinline__ int nstores(const Unit&, int) const { return 0; }
    __device__ __forceinline__ void operator()(AccRef acc, const Unit& u, int wr, int wc, int fr, int fq) const {
        const int row0 = u.pm * BM + wr * 64 + fr, col0 = u.pn * BM + wc * 32 + 8 * fq;
#pragma unroll
        for (int ai = 0; ai < 2; ++ai) {
            u32x4 xv[4][2];
#pragma unroll
            for (int m = 0; m < 4; ++m)
#pragma unroll
                for (int bj = 0; bj < 2; ++bj) xv[m][bj] = __builtin_nontemporal_load((const u32x4*)(xb + (size_t)(row0 + ai * HALF + m * 16) * DM + col0 + bj * HALF));
#pragma unroll
            for (int m = 0; m < 4; ++m) { const size_t off = (size_t)(row0 + ai * HALF + m * 16) * DM + col0;
#pragma unroll
                for (int bj = 0; bj < 2; ++bj) { const u32x4 xw = xv[m][bj];
                    const f32x4 x0 = {bf_lo(xw.x), bf_hi(xw.x), bf_lo(xw.y), bf_hi(xw.y)}, x1 = {bf_lo(xw.z), bf_hi(xw.z), bf_lo(xw.w), bf_hi(xw.w)};
                    const f32x4 v0 = x0 * ALPHA + acc[ai][bj][m][0], v1 = x1 * ALPHA + acc[ai][bj][m][1];
                    u32x4 w; w.x = cvt_pk_bf16(v0[0], v0[1]); w.y = cvt_pk_bf16(v0[2], v0[3]); w.z = cvt_pk_bf16(v1[0], v1[1]); w.w = cvt_pk_bf16(v1[2], v1[3]);
                    *(u32x4*)(y + off + bj * HALF) = w; } }
        }
    }
};
struct EpiGU {
    static constexpr bool PERM = true;
    unsigned char* hid;
    __device__ __forceinline__ int nstores(const Unit&, int) const { return 8; }
    __device__ __forceinline__ void operator()(AccRef acc, const Unit& u, int wr, int wc, int fr, int fq) const {
        const int row0 = u.pm * BM + wr * 64 + fr, col0 = (u.pn & 7) * 128 + wc * 32 + 8 * fq;
        EPI_LOOP_AM { unsigned char* rowp = hid + (size_t)(row0 + ai * HALF + m * 16) * FF + col0;
            f32x4 h[2];
#pragma unroll
            for (int n = 0; n < 2; ++n) { const f32x4 g = acc[ai][0][m][n], u = acc[ai][1][m][n]; const f32x4 t = g * (-1.4426950408889634f / 64.0f);
                f32x4 e; e[0] = __builtin_amdgcn_exp2f(t[0]); e[1] = __builtin_amdgcn_exp2f(t[1]); e[2] = __builtin_amdgcn_exp2f(t[2]); e[3] = __builtin_amdgcn_exp2f(t[3]);
                const f32x4 d = e + 1.0f; f32x4 sg; sg[0] = __builtin_amdgcn_rcpf(d[0]); sg[1] = __builtin_amdgcn_rcpf(d[1]); sg[2] = __builtin_amdgcn_rcpf(d[2]); sg[3] = __builtin_amdgcn_rcpf(d[3]);
                h[n] = (g * u) * (sg * (1.0f / 512.0f)); }
            u32x2 w; w.x = pk4_fp8(h[0][0], h[0][1], h[0][2], h[0][3]); w.y = pk4_fp8(h[1][0], h[1][1], h[1][2], h[1][3]);
            *(u32x2*)rowp = w; }
    }
};
struct EpiDown {
    static constexpr bool PERM = true;
    static constexpr bool PRELOAD = true;
    unsigned char* y; const float* gatev;
    __device__ __forceinline__ void preload(const Unit& u, int wr, int fr, float (&gv)[2][4]) const { const int row0 = u.pm * BM + wr * 64 + fr; EPI_LOOP_AM gv[ai][m] = gatev[row0 + ai * HALF + m * 16]; }
    __device__ __forceinline__ int nstores(const Unit&, int) const { return 16; }
    __device__ __forceinline__ void operator()(AccRef acc, const Unit& u, int wr, int wc, int fr, int fq, const float (&gv)[2][4]) const {
        const int row0 = u.pm * BM + wr * 64 + fr, col0 = (u.pn & 7) * BM + wc * 32 + 8 * fq;
        EPI_LOOP_AM { const int row = row0 + ai * HALF + m * 16; const float g = gv[ai][m]; unsigned char* rowp = y + (size_t)row * DM + col0;
#pragma unroll
            for (int bj = 0; bj < 2; ++bj) { const f32x4 v0 = acc[ai][bj][m][0] * g, v1 = acc[ai][bj][m][1] * g;
                u32x2 w; w.x = pk4_fp8(v0[0], v0[1], v0[2], v0[3]); w.y = pk4_fp8(v1[0], v1[1], v1[2], v1[3]);
                *(u32x2*)(rowp + bj * HALF) = w; } }
    }
};
struct EpiPlain {
    static constexpr bool PERM = true;
    bf16_t* o;
    __device__ __forceinline__ int nstores(const Unit&, int) const { return 16; }
    __device__ __forceinline__ void operator()(AccRef acc, const Unit& u, int wr, int wc, int fr, int fq) const {
        const int row0 = u.pm * BM + wr * 64 + fr, col0 = u.pn * BM + wc * 32 + 8 * fq;
        EPI_LOOP_AM { bf16_t* rowp = o + (size_t)(row0 + ai * HALF + m * 16) * DM + col0;
#pragma unroll
            for (int bj = 0; bj < 2; ++bj) { const f32x4 v0 = acc[ai][bj][m][0], v1 = acc[ai][bj][m][1];
                u32x4 w; w.x = cvt_pk_bf16(v0[0], v0[1]); w.y = cvt_pk_bf16(v0[2], v0[3]); w.z = cvt_pk_bf16(v1[0], v1[1]); w.w = cvt_pk_bf16(v1[2], v1[3]);
                *(u32x4*)(rowp + bj * HALF) = w; } }
    }
};
struct EpiPlGate {
    static constexpr bool PERM = true;
    bf16_t* o; const float* bias;
    __device__ __forceinline__ int nstores(const Unit&, int) const { return 0; }
    __device__ __forceinline__ void operator()(AccRef acc, const Unit& u, int wr, int wc, int fr, int fq) const {
        const int row0 = u.pm * BM + wr * 64 + fr, col0 = u.pn * BM + wc * 32 + 8 * fq;
        f32x4 bv[2][2];
#pragma unroll
        for (int bj = 0; bj < 2; ++bj)
#pragma unroll
            for (int n = 0; n < 2; ++n) bv[bj][n] = *(const f32x4*)(bias + col0 + bj * HALF + 4 * n);
        f32x4 nb[2][2];
#pragma unroll
        for (int bj = 0; bj < 2; ++bj)
#pragma unroll
            for (int n = 0; n < 2; ++n) nb[bj][n] = bv[bj][n] * -1.4426950408889634f;
        EPI_LOOP_AM { bf16_t* rowp = o + (size_t)(row0 + ai * HALF + m * 16) * DM + col0;
#pragma unroll
            for (int bj = 0; bj < 2; ++bj) { const u32x4 pw = *(const u32x4*)(rowp + bj * HALF);
                const f32x4 t0 = acc[ai][bj][m][0] * (-1.4426950408889634f / 64.0f) + nb[bj][0], t1 = acc[ai][bj][m][1] * (-1.4426950408889634f / 64.0f) + nb[bj][1];
                f32x4 e0, e1;
#pragma unroll
                for (int q = 0; q < 4; ++q) { e0[q] = __builtin_amdgcn_exp2f(t0[q]); e1[q] = __builtin_amdgcn_exp2f(t1[q]); }
                const f32x4 d0 = e0 + 1.0f, d1 = e1 + 1.0f; f32x4 s0, s1;
#pragma unroll
                for (int q = 0; q < 4; ++q) { s0[q] = __builtin_amdgcn_rcpf(d0[q]); s1[q] = __builtin_amdgcn_rcpf(d1[q]); }
                const f32x4 p0 = {bf_lo(pw.x), bf_hi(pw.x), bf_lo(pw.y), bf_hi(pw.y)}, p1 = {bf_lo(pw.z), bf_hi(pw.z), bf_lo(pw.w), bf_hi(pw.w)};
                const f32x4 o0 = s0 * p0, o1 = s1 * p1;
                u32x4 w; w.x = cvt_pk_bf16(o0[0], o0[1]); w.y = cvt_pk_bf16(o0[2], o0[3]); w.z = cvt_pk_bf16(o1[0], o1[1]); w.w = cvt_pk_bf16(o1[2], o1[3]);
                *(u32x4*)(rowp + bj * HALF) = w; } }
    }
};
}

namespace att {
constexpr int D = 128, NW = 8, QBLK = 32, KVBLK = 64;
constexpr float SCALE = 0.088388347648318440f;
constexpr float THR = 8.f;
constexpr int LDQ = PJ_LD, LDK = PJ_LD, LDO = DM;
constexpr size_t SHM_V = KVBLK * D * 2, SHM_K = KVBLK * D * 2;
#define KSWZ(row, colB) ((row) * 256 + ((colB) ^ (((row) & 7) << 4)))
#define SBAR() __builtin_amdgcn_sched_barrier(0)
__device__ __forceinline__ int crow(int r, int hi) { return (r & 3) + 8 * (r >> 2) + 4 * hi; }
__device__ __forceinline__ unsigned cvtpk(float lo, float hi) { unsigned r; asm volatile("v_cvt_pk_bf16_f32 %0, %1, %2" : "=v"(r) : "v"(lo), "v"(hi)); return r; }
__device__ __forceinline__ bf16x8 ld8(const bf16_t* p) { return *reinterpret_cast<const bf16x8*>(p); }

__device__ __forceinline__ void partialSM(f32x16& p0, f32x16& p1, float& m_reg, float& mn, float& alpha) {
    constexpr float C = SCALE * 1.4426950408889634f;
    float pmax = p0[0]; for (int r = 1; r < 16; ++r) pmax = fmaxf(pmax, p0[r]); for (int r = 0; r < 16; ++r) pmax = fmaxf(pmax, p1[r]);
    { auto rr = __builtin_amdgcn_permlane32_swap(__float_as_uint(pmax), __float_as_uint(pmax), false, false);
      pmax = fmaxf(__uint_as_float(rr[0]), __uint_as_float(rr[1])); }
    if (__builtin_expect(__all(pmax - m_reg <= THR / SCALE), 1)) { mn = m_reg; alpha = 1.f; }
    else { mn = fmaxf(m_reg, pmax); alpha = __builtin_amdgcn_exp2f((m_reg - mn) * C); m_reg = mn; }
    float mnC = -mn * C;
    for (int r = 0; r < 16; ++r) p0[r] = fmaf(p0[r], C, mnC); for (int r = 0; r < 16; ++r) p1[r] = fmaf(p1[r], C, mnC);
    for (int r = 0; r < 16; ++r) p0[r] = __builtin_amdgcn_exp2f(p0[r]);
}
__device__ __forceinline__ void finishSM(f32x16& p0, f32x16& p1, float alpha, float& l_reg, bf16x8& pa0, bf16x8& pa1, bf16x8& pa2, bf16x8& pa3) {
    for (int r = 0; r < 16; ++r) p1[r] = __builtin_amdgcn_exp2f(p1[r]);
    float ps = 0; for (int r = 0; r < 16; ++r) ps += p0[r]; for (int r = 0; r < 16; ++r) ps += p1[r];
    { auto rr = __builtin_amdgcn_permlane32_swap(__float_as_uint(ps), __float_as_uint(ps), false, false);
      ps = __uint_as_float(rr[0]) + __uint_as_float(rr[1]); }
    l_reg = l_reg * alpha + ps;
#define PK4(P, BASE, OUT) do { unsigned a0 = cvtpk(P[BASE + 0], P[BASE + 1]), a1 = cvtpk(P[BASE + 2], P[BASE + 3]);   \
    unsigned b0 = cvtpk(P[BASE + 4], P[BASE + 5]), b1 = cvtpk(P[BASE + 6], P[BASE + 7]);                              \
    auto r0 = __builtin_amdgcn_permlane32_swap(a0, b0, false, false); auto r1 = __builtin_amdgcn_permlane32_swap(a1, b1, false, false); \
    u32x4 w = {r0[0], r1[0], r0[1], r1[1]}; OUT = *reinterpret_cast<bf16x8*>(&w); } while (0)
    PK4(p0, 0, pa0); PK4(p0, 8, pa1); PK4(p1, 0, pa2); PK4(p1, 8, pa3);
#undef PK4
}
__device__ __forceinline__ void qkt(f32x16& p0, f32x16& p1, const bf16_t* Ks, const bf16x8* qr, int r32, int hi) {
    p0 = f32x16{}; p1 = f32x16{};
    for (int d0 = 0; d0 < 8; ++d0) { int cb = (d0 * 16 + hi * 8) * 2;
        bf16x8 b0 = *reinterpret_cast<const bf16x8*>((const char*)Ks + KSWZ(r32, cb));
        bf16x8 b1 = *reinterpret_cast<const bf16x8*>((const char*)Ks + KSWZ(32 + r32, cb));
        p0 = __builtin_amdgcn_mfma_f32_32x32x16_bf16(b0, qr[d0], p0, 0, 0, 0);
        p1 = __builtin_amdgcn_mfma_f32_32x32x16_bf16(b1, qr[d0], p1, 0, 0, 0); }
}
__device__ __forceinline__ int v_st(int k, int c) { const int kk = (k & ~0xC) | ((k & 4) << 1) | ((k & 8) >> 1); return ((kk >> 3) * 4 + (c >> 5)) * 512 + ((kk & 7) * 32 + (c & 31)) * 2; }
__device__ __forceinline__ int v_rd_base(int lane) { return ((lane & 3) << 3) | (((lane >> 2) & 3) << 6) | (((lane >> 4) & 1) << 5) | (((lane >> 5) & 1) << 8); }
constexpr int v_rd_off(int d0, int ks, int half) { return d0 * 512 + ks * 4096 + half * 2048; }
template <int OFF> __device__ __forceinline__ s16x4 tr_read(int vb) {
    s16x4 r; asm volatile("ds_read_b64_tr_b16 %0, %1 offset:%2" : "=&v"(r) : "v"(vb), "i"(OFF) : "memory"); return r;
}
template <int D0> __device__ __forceinline__ void pv_one(f32x16& od, int vb, bf16x8 pa0, bf16x8 pa1, bf16x8 pa2, bf16x8 pa3) {
    const s16x4 l0 = tr_read<v_rd_off(D0, 0, 0)>(vb), h0 = tr_read<v_rd_off(D0, 0, 1)>(vb), l1 = tr_read<v_rd_off(D0, 1, 0)>(vb), h1 = tr_read<v_rd_off(D0, 1, 1)>(vb);
    const s16x4 l2 = tr_read<v_rd_off(D0, 2, 0)>(vb), h2 = tr_read<v_rd_off(D0, 2, 1)>(vb), l3 = tr_read<v_rd_off(D0, 3, 0)>(vb), h3 = tr_read<v_rd_off(D0, 3, 1)>(vb);
    asm volatile("s_waitcnt lgkmcnt(0)" ::: "memory"); SBAR();
#define PK(L, H) (bf16x8){L[0], L[1], L[2], L[3], H[0], H[1], H[2], H[3]}
    od = __builtin_amdgcn_mfma_f32_32x32x16_bf16(pa0, PK(l0, h0), od, 0, 0, 0);
    od = __builtin_amdgcn_mfma_f32_32x32x16_bf16(pa1, PK(l1, h1), od, 0, 0, 0);
    od = __builtin_amdgcn_mfma_f32_32x32x16_bf16(pa2, PK(l2, h2), od, 0, 0, 0);
    od = __builtin_amdgcn_mfma_f32_32x32x16_bf16(pa3, PK(l3, h3), od, 0, 0, 0);
#undef PK
}
__device__ __forceinline__ void pv_d0(f32x16* o, int vb, bf16x8 pa0, bf16x8 pa1, bf16x8 pa2, bf16x8 pa3) {
    pv_one<0>(o[0], vb, pa0, pa1, pa2, pa3); pv_one<1>(o[1], vb, pa0, pa1, pa2, pa3); pv_one<2>(o[2], vb, pa0, pa1, pa2, pa3); pv_one<3>(o[3], vb, pa0, pa1, pa2, pa3);
}
__device__ __forceinline__ void attn_dense_body(const bf16_t* __restrict__ Qb, const bf16_t* __restrict__ Kh, const bf16_t* __restrict__ Vh, bf16_t* __restrict__ Ob, int seq, char* lds, const float* __restrict__ gq, const float* __restrict__ rtab, int s_base) {
    const int tid = threadIdx.x, wid = tid >> 6, lane = tid & 63, r32 = lane & 31, hi = lane >> 5;
    bf16_t* V_lds = (bf16_t*)lds; bf16_t* K_lds = (bf16_t*)(lds + 2 * SHM_V);
    float* wsl = (float*)(lds + 2 * SHM_V + 2 * SHM_K) + wid * 64; float* li_l = wsl; float* al_l = wsl + 32;
    float m_reg = -1e30f, l_reg = 0; f32x16 o[4] = {}; bf16x8 qr[8];
    const bf16_t* Qw = Qb + (long)(wid * QBLK + r32) * LDQ + hi * 8;
    {
        int h8 = hi * 8; asm volatile("" : "+v"(h8));
        bf16x8 qraw[8];
#pragma unroll
        for (int d0 = 0; d0 < 8; ++d0) qraw[d0] = ld8(Qw + d0 * 16);
        float ss = 0.f;
#pragma unroll
        for (int d0 = 0; d0 < 8; ++d0)
#pragma unroll
            for (int j = 0; j < 8; ++j) { const float v = __uint_as_float(((unsigned)(unsigned short)qraw[d0][j]) << 16); ss += v * v; }
        { auto rr = __builtin_amdgcn_permlane32_swap(__float_as_uint(ss), __float_as_uint(ss), false, false); ss = __uint_as_float(rr[0]) + __uint_as_float(rr[1]); }
        const float rn = rsqrtf(ss * (1.0f / 128.0f) + NORM_EPS);
        const int s_tok = s_base + wid * QBLK + r32;
#pragma unroll
        for (int ax = 0; ax < 2; ++ax)
#pragma unroll
            for (int fb = 0; fb < 2; ++fb) { const int pos = ax ? (s_tok & 63) : (s_tok >> 6); const float* ct = rtab + pos * 32 + fb * 16 + h8;
                const f32x4 c0 = *(const f32x4*)ct, c1 = *(const f32x4*)(ct + 4), s0 = *(const f32x4*)(ct + 2048), s1 = *(const f32x4*)(ct + 2052);
                const float cs[8] = {c0[0], c0[1], c0[2], c0[3], c1[0], c1[1], c1[2], c1[3]}, sn[8] = {s0[0], s0[1], s0[2], s0[3], s1[0], s1[1], s1[2], s1[3]};
                const int da = ax * 4 + fb, db = da + 2;
                const f32x4 ga0 = *(const f32x4*)(gq + da * 16 + h8), ga1 = *(const f32x4*)(gq + da * 16 + h8 + 4), gb0 = *(const f32x4*)(gq + db * 16 + h8), gb1 = *(const f32x4*)(gq + db * 16 + h8 + 4);
                const float gA[8] = {ga0[0], ga0[1], ga0[2], ga0[3], ga1[0], ga1[1], ga1[2], ga1[3]}, gB[8] = {gb0[0], gb0[1], gb0[2], gb0[3], gb1[0], gb1[1], gb1[2], gb1[3]};
                float xa[8], xb_[8];
#pragma unroll
                for (int j = 0; j < 8; ++j) { xa[j] = __uint_as_float(((unsigned)(unsigned short)qraw[da][j]) << 16) * rn * gA[j]; xb_[j] = __uint_as_float(((unsigned)(unsigned short)qraw[db][j]) << 16) * rn * gB[j]; }
                u32x4 wa, wb; float oa[8], ob[8];
#pragma unroll
                for (int j = 0; j < 8; ++j) { oa[j] = xa[j] * cs[j] - xb_[j] * sn[j]; ob[j] = xb_[j] * cs[j] + xa[j] * sn[j]; }
                wa.x = cvt_pk_bf16(oa[0], oa[1]); wa.y = cvt_pk_bf16(oa[2], oa[3]); wa.z = cvt_pk_bf16(oa[4], oa[5]); wa.w = cvt_pk_bf16(oa[6], oa[7]);
                wb.x = cvt_pk_bf16(ob[0], ob[1]); wb.y = cvt_pk_bf16(ob[2], ob[3]); wb.z = cvt_pk_bf16(ob[4], ob[5]); wb.w = cvt_pk_bf16(ob[6], ob[7]);
                qr[da] = __builtin_bit_cast(bf16x8, wa); qr[db] = __builtin_bit_cast(bf16x8, wb); }
    }
    const int sr = tid >> 4, sc = (tid & 15) * 8, vst0 = v_st(sr, sc), vst1 = v_st(32 + sr, sc);
    const int vb0 = (int)(uintptr_t)V_lds + v_rd_base(lane);
    struct { bf16x8 vs0, vs1, ks0, ks1; } sr_[2];
#define SLOAD(i, k0) do { sr_[i].vs0 = ld8(&Vh[(long)((k0) + sr) * LDK + sc]); sr_[i].vs1 = ld8(&Vh[(long)((k0) + 32 + sr) * LDK + sc]); \
    sr_[i].ks0 = ld8(&Kh[(long)((k0) + sr) * LDK + sc]); sr_[i].ks1 = ld8(&Kh[(long)((k0) + 32 + sr) * LDK + sc]); } while (0)
#define SWRITE(b, i) do { *(bf16x8*)((char*)V_lds + (b) * SHM_V + vst0) = sr_[i].vs0;          \
    *(bf16x8*)((char*)V_lds + (b) * SHM_V + vst1) = sr_[i].vs1; int kc = sc * 2;               \
    *(bf16x8*)((char*)K_lds + (b) * SHM_K + KSWZ(sr, kc)) = sr_[i].ks0;                       \
    *(bf16x8*)((char*)K_lds + (b) * SHM_K + KSWZ(32 + sr, kc)) = sr_[i].ks1; } while (0)
#define SWAIT() asm volatile("s_waitcnt vmcnt(4)" ::: "memory")
#define RESC(a) do { if (__any((a) < 1.f)) { if (hi == 0) al_l[r32] = (a); asm volatile("s_waitcnt lgkmcnt(0)" ::: "memory"); \
    for (int d = 0; d < 4; ++d) for (int r = 0; r < 16; ++r) o[d][r] *= al_l[crow(r, hi)]; } } while (0)
    f32x16 pA0, pA1, pB0, pB1; float mnA, mnB, alA, alB; bf16x8 pa0, pa1, pa2, pa3; const int NT = seq / KVBLK;
    constexpr int SE = 0, SO = 1;
    SLOAD(SE, 0); asm volatile("s_waitcnt vmcnt(0)" ::: "memory"); SWRITE(0, SE); __syncthreads();
    qkt(pA0, pA1, K_lds, qr, r32, hi); partialSM(pA0, pA1, m_reg, mnA, alA);
    SLOAD(SO, KVBLK); if (2 < NT) SLOAD(SE, 2 * KVBLK);
    SWAIT(); SWRITE(1, SO); __syncthreads();
    for (int j = 1; j + 1 < NT; j += 2) {
        SBAR(); qkt(pB0, pB1, (bf16_t*)((char*)K_lds + SHM_K), qr, r32, hi);
        finishSM(pA0, pA1, alA, l_reg, pa0, pa1, pa2, pa3); SBAR();
        SLOAD(SO, (j + 2) * KVBLK); SBAR();
        pv_d0(o, vb0, pa0, pa1, pa2, pa3); partialSM(pB0, pB1, m_reg, mnB, alB);
        __syncthreads(); SWAIT(); SWRITE(0, SE);
        RESC(alB); __syncthreads();
        SBAR(); qkt(pA0, pA1, K_lds, qr, r32, hi);
        finishSM(pB0, pB1, alB, l_reg, pa0, pa1, pa2, pa3); SBAR();
        if (j + 3 < NT) SLOAD(SE, (j + 3) * KVBLK); SBAR();
        pv_d0(o, vb0 + (int)SHM_V, pa0, pa1, pa2, pa3); partialSM(pA0, pA1, m_reg, mnA, alA);
        __syncthreads(); SWAIT(); SWRITE(1, SO);
        RESC(alA); __syncthreads();
    }
    SBAR(); qkt(pB0, pB1, (bf16_t*)((char*)K_lds + SHM_K), qr, r32, hi);
    finishSM(pA0, pA1, alA, l_reg, pa0, pa1, pa2, pa3); SBAR();
    pv_d0(o, vb0, pa0, pa1, pa2, pa3); partialSM(pB0, pB1, m_reg, mnB, alB);
    __syncthreads(); RESC(alB);
    finishSM(pB0, pB1, alB, l_reg, pa0, pa1, pa2, pa3); SBAR();
    pv_d0(o, vb0 + (int)SHM_V, pa0, pa1, pa2, pa3);
    if (hi == 0) li_l[r32] = l_reg; asm volatile("s_waitcnt lgkmcnt(0)" ::: "memory");
    float rli[16];
#pragma unroll
    for (int r = 0; r < 16; ++r) rli[r] = __builtin_amdgcn_rcpf(li_l[crow(r, hi)]);
    bf16_t* Ow = Ob + (long)(wid * QBLK) * LDO;
#pragma unroll
    for (int r = 0; r < 16; ++r) { int orow = crow(r, hi);
        for (int d0 = 0; d0 < 4; ++d0) Ow[(long)orow * LDO + d0 * 32 + r32] = (bf16_t)f2bf(o[d0][r] * rli[r]); }
    __syncthreads();
#undef SLOAD
#undef SWRITE
#undef SWAIT
#undef RESC
}
#undef KSWZ
#undef SBAR
}

__device__ __forceinline__ void tr_desc(const Params& p, int r, const float*& src, int& ld, unsigned char*& dst, int& pitch, int& f8) {
    unsigned char* ws = p.ws;
    constexpr int I0 = 32 * 145, I1 = 32 * 64, I2 = 32 * 64, I3 = 4 * 64, I4 = 16 * 32 * 64;
    f8 = 0;
    if (r < I0) { const int kb = r / 145, nb = r % 145, dn0 = nb * 32; const int sc = dn0 < 1536 ? 3104 + dn0 : (dn0 < 4608 ? dn0 - 1536 : 3072);
        src = p.in[I_WIN] + (size_t)(kb * 64) * 4640 + sc; ld = 4640; dst = ws + WS_WIN + ((size_t)dn0 * 2048 + kb * 64) * 2; pitch = 4096; return; } r -= I0;
    if (r < I1) { const int kb = r / 64, nb = r % 64;
        src = p.in[I_WOUT] + (size_t)(kb * 64) * 2048 + nb * 32; ld = 2048; dst = ws + WS_WOUT + ((size_t)(nb * 32) * 2048 + kb * 64) * 2; pitch = 4096; return; } r -= I1;
    if (r < I2) { const int kb = r / 64, nb = r % 64;
        src = p.in[I_WPG] + (size_t)(kb * 64) * 2048 + nb * 32; ld = 2048; dst = ws + WS_WPG + (size_t)(nb * 32) * 2048 + kb * 64; pitch = 2048; f8 = 1; return; } r -= I2;
    if (r < I3) { const int kb = r / 64, nb = r % 64;
        src = p.in[I_WPP] + (size_t)(kb * 64) * 2048 + nb * 32; ld = 2048; dst = ws + WS_WPP + ((size_t)(nb * 32) * 256 + kb * 64) * 2; pitch = 512; return; } r -= I3;
    f8 = 1;
    if (r < I4) { const int e = r / 2048, q = r % 2048, kb = q / 64, nb = q % 64, dn0 = nb * 32, t = dn0 >> 8, hlf = (dn0 >> 7) & 1, j0 = dn0 & 127;
        src = (hlf ? p.in[I_WU] : p.in[I_WG]) + (size_t)e * 2048 * 1024 + (size_t)(kb * 64) * 1024 + t * 128 + j0; ld = 1024;
        dst = ws + WS_WGU + (size_t)(e * 2048 + dn0) * 2048 + kb * 64; pitch = 2048; return; } r -= I4;
    { const int e = r / 1024, q = r % 1024, kb = q / 64, nb = q % 64;
        src = p.in[I_WD] + (size_t)e * 1024 * 2048 + (size_t)(kb * 64) * 2048 + nb * 32; ld = 2048; dst = ws + WS_WDN + (size_t)(e * 2048 + nb * 32) * 1024 + kb * 64; pitch = 1024; }
}
constexpr int TR_BUF = 8 * 1040;
__device__ __forceinline__ void tr_loop(const Params& p, LAS unsigned char* scr, int lane_in, int first, int end, int stride) {
    if (first >= end) return;
    int lane = lane_in; asm volatile("" : "+v"(lane));
    const int lr = lane >> 3, lc = (lane & 7) * 4;
    const float* src; int ld; unsigned char* dst; int pitch, f8;
    unsigned char* dst1; int pitch1, f81;
#define TR_ISSUE(boff, SRC, LD) do { _Pragma("unroll") for (int i = 0; i < 8; ++i) \
        __builtin_amdgcn_global_load_lds((const unsigned*)((SRC) + (size_t)(8 * i + lr) * (LD) + lc), (LAS unsigned*)(scr + (boff) + i * 1040), 16, 0, 2); } while (0)
    tr_desc(p, first, src, ld, dst, pitch, f8);
    TR_ISSUE(0, src, ld);
    { const int i1 = first + stride < end ? first + stride : first; tr_desc(p, i1, src, ld, dst1, pitch1, f81); TR_ISSUE(TR_BUF, src, ld); }
    int boff = 0;
    for (int it = first; it < end; it += stride) {
        if (it == first) asm volatile("s_waitcnt vmcnt(8)" ::: "memory"); else asm volatile("s_waitcnt vmcnt(10)" ::: "memory");
        float v[32];
        if (f8) {
            const LAS float* s_ = (const LAS float*)(scr + boff) + (2 * (lane & 3)) * 260 + (lane >> 2);
#pragma unroll
            for (int j = 0; j < 2; ++j)
#pragma unroll
                for (int i = 0; i < 16; ++i) v[j * 16 + i] = s_[(i >> 3) * 260 + (i & 7) * 32 + 16 * j];
        } else {
            const LAS float* s_ = (const LAS float*)(scr + boff) + (lane & 7) * 260 + (lane >> 3);
#pragma unroll
            for (int j = 0; j < 4; ++j)
#pragma unroll
                for (int i = 0; i < 8; ++i) v[j * 8 + i] = s_[i * 32 + 8 * j];
        }
        LDS_WAIT(); asm volatile("" ::: "memory");
        { int i2 = it + 2 * stride; if (i2 >= end) i2 = it + stride < end ? it + stride : it;
          const float* src2; int ld2; unsigned char* dst2; int pitch2, f82;
          tr_desc(p, i2, src2, ld2, dst2, pitch2, f82);
          TR_ISSUE(boff, src2, ld2);
          if (f8) {
              const int c = lane & 3;
#pragma unroll
              for (int j = 0; j < 2; ++j) { const int n = (lane >> 2) + 16 * j; const float* w_ = v + 16 * j;
                  u32x4 o; o.x = pk4_fp8(w_[0] * 8.f, w_[1] * 8.f, w_[2] * 8.f, w_[3] * 8.f); o.y = pk4_fp8(w_[4] * 8.f, w_[5] * 8.f, w_[6] * 8.f, w_[7] * 8.f);
                  o.z = pk4_fp8(w_[8] * 8.f, w_[9] * 8.f, w_[10] * 8.f, w_[11] * 8.f); o.w = pk4_fp8(w_[12] * 8.f, w_[13] * 8.f, w_[14] * 8.f, w_[15] * 8.f);
                  __builtin_nontemporal_store(o, (u32x4*)(dst + (size_t)n * pitch + 16 * c)); }
          } else {
              const int c = lane & 7;
#pragma unroll
              for (int j = 0; j < 4; ++j) { const int n = (lane >> 3) + 8 * j; const float* w_ = v + 8 * j;
                  u32x4 o; o.x = cvt_pk_bf16(w_[0], w_[1]); o.y = cvt_pk_bf16(w_[2], w_[3]); o.z = cvt_pk_bf16(w_[4], w_[5]); o.w = cvt_pk_bf16(w_[6], w_[7]);
                  *(u32x4*)(dst + (size_t)n * pitch + 16 * c) = o; }
          }
          dst = dst1; pitch = pitch1; f8 = f81; dst1 = dst2; pitch1 = pitch2; f81 = f82; }
        boff ^= TR_BUF;
    }
    VM_WAIT();
#undef TR_ISSUE
}
constexpr int TR_SMALL = 32 * 145 + 32 * 64 + 32 * 64 + 4 * 64;
constexpr int TR_ALL = TR_SMALL + 16 * 32 * 64 + 16 * 16 * 64;
__device__ __forceinline__ void phase0(const Params& p, LAS unsigned char* lds, int gw, int NGW, int wave, int lane) {
    unsigned char* ws = p.ws;
    tr_loop(p, lds + wave * (2 * TR_BUF), lane, gw, TR_SMALL, NGW);
    const size_t gt = (size_t)gw * 64 + lane, GT = (size_t)NGW * 64;
#define CVT_PASS(SRC, DST, N8) do { const float* x_ = (SRC); bf16_t* xb_ = (DST); \
      for (size_t i = gt; i < (size_t)(N8); i += 4 * GT) { f32x4 a_[4], b_[4]; \
          _Pragma("unroll") for (int u = 0; u < 4; ++u) { const size_t k_ = i + u * GT; a_[u] = __builtin_nontemporal_load((const f32x4*)(x_ + k_ * 8)); b_[u] = __builtin_nontemporal_load((const f32x4*)(x_ + k_ * 8 + 4)); } \
          _Pragma("unroll") for (int u = 0; u < 4; ++u) { const size_t k_ = i + u * GT; u32x4 w_; w_.x = cvt_pk_bf16(a_[u][0], a_[u][1]); w_.y = cvt_pk_bf16(a_[u][2], a_[u][3]); w_.z = cvt_pk_bf16(b_[u][0], b_[u][1]); w_.w = cvt_pk_bf16(b_[u][2], b_[u][3]); *(u32x4*)(xb_ + k_ * 8) = w_; } } } while (0)
    static_assert(((size_t)NTOK * 256 / 8) % (4 * 131072) == 0, "conversion batches assume a 256 x 512 grid");
    CVT_PASS(p.in[I_P], (bf16_t*)(ws + WS_PB), (size_t)NTOK * 256 / 8);
#undef CVT_PASS
    { constexpr int WROW = 4096 + 16; const float* win = p.in[I_WIN]; const float* x = p.in[I_X]; bf16_t* xb = (bf16_t*)(ws + WS_RB); float* gates = (float*)(ws + WS_GATES);
      const int fr = lane & 15, fq = lane >> 4;
      __syncthreads();
      for (int i0 = threadIdx.x; i0 < 2048 * 8; i0 += 8 * 512) {
          f32x4 w[8];
#pragma unroll
          for (int u = 0; u < 8; ++u) { const int i = i0 + u * 512, k = i >> 3, c4 = i & 7; w[u] = *(const f32x4*)(win + (size_t)k * 4640 + 3072 + c4 * 4); }
#pragma unroll
          for (int u = 0; u < 8; ++u) { const int i = i0 + u * 512, k = i >> 3, c4 = i & 7;
#pragma unroll
              for (int j = 0; j < 4; ++j) *(LAS bf16_t*)(lds + (c4 * 4 + j) * WROW + k * 2) = (bf16_t)f2bf(w[u][j]); } }
      __syncthreads();
      for (int task = gw; task < NTOK / 16; task += NGW) {
          const int row0 = task * 16; const float* xp = x + (size_t)(row0 + fr) * DM + fq * 8; bf16_t* xo = xb + (size_t)(row0 + fr) * DM + fq * 8;
          const LAS unsigned char* b0p = lds + fr * WROW + fq * 16; const LAS unsigned char* b1p = b0p + 16 * WROW;
          f32x4 acc0 = {0.f, 0.f, 0.f, 0.f}, acc1 = {0.f, 0.f, 0.f, 0.f};
          f32x4 la[8][2], lb2[8][2];
#define X_LOAD(BUF, blk) do { _Pragma("unroll") for (int i_ = 0; i_ < 8; ++i_) { BUF[i_][0] = __builtin_nontemporal_load((const f32x4*)(xp + ((blk) * 8 + i_) * 32)); BUF[i_][1] = __builtin_nontemporal_load((const f32x4*)(xp + ((blk) * 8 + i_) * 32 + 4)); } } while (0)
#define X_PROC(BUF, blk) do { _Pragma("unroll") for (int i_ = 0; i_ < 8; ++i_) { const int ks = (blk) * 8 + i_; const f32x4 lo = BUF[i_][0], hi = BUF[i_][1]; \
              u32x4 w; w.x = cvt_pk_bf16(lo[0], lo[1]); w.y = cvt_pk_bf16(lo[2], lo[3]); w.z = cvt_pk_bf16(hi[0], hi[1]); w.w = cvt_pk_bf16(hi[2], hi[3]); \
              *(u32x4*)(xo + ks * 32) = w; \
              const bf16x8 a = __builtin_bit_cast(bf16x8, w), b0 = *(const LAS bf16x8*)(b0p + ks * 64), b1 = *(const LAS bf16x8*)(b1p + ks * 64); \
              acc0 = __builtin_amdgcn_mfma_f32_16x16x32_bf16(a, b0, acc0, 0, 0, 0); acc1 = __builtin_amdgcn_mfma_f32_16x16x32_bf16(a, b1, acc1, 0, 0, 0); } } while (0)
          X_LOAD(la, 0);
#pragma unroll 1
          for (int blk = 0; blk < 8; blk += 2) {
              X_LOAD(lb2, blk + 1);
              X_PROC(la, blk);
              if (blk + 2 < 8) X_LOAD(la, blk + 2);
              X_PROC(lb2, blk + 1);
          }
#undef X_LOAD
#undef X_PROC
#pragma unroll
          for (int r = 0; r < 4; ++r) { float* gp = gates + (size_t)(row0 + 4 * fq + r) * 32 + fr; gp[0] = acc0[r]; gp[16] = acc1[r]; }
      }
      __syncthreads(); }
    { float* tab = (float*)(ws + WS_ROPE);
      for (size_t i = gt; i < 2048; i += GT) { const int pos = (int)i >> 5, f = (int)i & 31; const float inv = powf(10000.0f, -(float)f / 32.0f); const float ang = (float)pos * inv;
          tab[i] = cosf(ang); tab[2048 + i] = sinf(ang); } }
    { float* wrt = (float*)(ws + WS_WRT); const float* wr = p.in[I_WR];
      for (size_t i = gt; i < 16 * 2048; i += GT) { const int e = (int)i >> 11, d = (int)i & 2047; wrt[i] = wr[d * 16 + e]; } }
}

__device__ __forceinline__ void phase_normrope(const Params& p, int gw, int NGW, int lane) {
    bf16_t* proj = (bf16_t*)(p.ws + WS_RA); const float* tab = (const float*)(p.ws + WS_ROPE);
    const int grp = lane >> 4, li = lane & 15;
    const int half = (li >> 2) & 1, f0 = (li & 3) * 8;
    const f32x4 gk0 = *(const f32x4*)(p.in[I_GK] + li * 8), gk1 = *(const f32x4*)(p.in[I_GK] + li * 8 + 4);
    const float g[8] = {gk0[0], gk0[1], gk0[2], gk0[3], gk1[0], gk1[1], gk1[2], gk1[3]};
    constexpr int NIT = NTOK * 2 / 4;
    static_assert(NIT % (4 * 2048) == 0, "normrope batches assume a 256 x 8-wave grid");
    for (int it0 = gw; it0 < NIT; it0 += 4 * NGW) {
        u32x4 raw[4]; f32x4 c0[4], c1[4], s0[4], s1[4]; bf16_t* ptr[4];
#pragma unroll
        for (int u = 0; u < 4; ++u) { const int pair = (it0 + u * NGW) * 4 + grp, tok = pair >> 1, hd = 8 + (pair & 1);
            ptr[u] = proj + (size_t)tok * PJ_LD + hd * 128 + li * 8; raw[u] = *(const u32x4*)ptr[u];
            const int s_ = tok & (SEQ - 1), pos = (li < 8) ? (s_ >> 6) : (s_ & 63); const float* ct = tab + pos * 32 + f0;
            c0[u] = *(const f32x4*)ct; c1[u] = *(const f32x4*)(ct + 4); s0[u] = *(const f32x4*)(ct + 2048); s1[u] = *(const f32x4*)(ct + 2052); }
#pragma unroll
        for (int u = 0; u < 4; ++u) {
            const float x[8] = {bf_lo(raw[u].x), bf_hi(raw[u].x), bf_lo(raw[u].y), bf_hi(raw[u].y), bf_lo(raw[u].z), bf_hi(raw[u].z), bf_lo(raw[u].w), bf_hi(raw[u].w)};
            float ss = 0.f;
#pragma unroll
            for (int j = 0; j < 8; ++j) ss += x[j] * x[j];
            ss = row_sum16(ss);
            const float r = rsqrtf(ss * (1.0f / 128.0f) + NORM_EPS);
            const float cs[8] = {c0[u][0], c0[u][1], c0[u][2], c0[u][3], c1[u][0], c1[u][1], c1[u][2], c1[u][3]};
            const float sn[8] = {s0[u][0], s0[u][1], s0[u][2], s0[u][3], s1[u][0], s1[u][1], s1[u][2], s1[u][3]};
            float o[8];
#pragma unroll
            for (int j = 0; j < 8; ++j) { const float xn = x[j] * r * g[j]; const float pr = lane_xor4(xn, lane); o[j] = xn * cs[j] + (half ? pr : -pr) * sn[j]; }
            u32x4 w; w.x = cvt_pk_bf16(o[0], o[1]); w.y = cvt_pk_bf16(o[2], o[3]); w.z = cvt_pk_bf16(o[4], o[5]); w.w = cvt_pk_bf16(o[6], o[7]);
            *(u32x4*)ptr[u] = w; }
    }
}

__device__ __forceinline__ void phase_convsilu(const Params& p, int gw, int NGW, int lane) {
    const bf16_t* proj = (const bf16_t*)(p.ws + WS_RA); bf16_t* qkc = (bf16_t*)(p.ws + WS_RE); const float* convw = p.in[I_CONVW];
    for (int task = gw; task < NTOK / 16 * 2; task += NGW) {
        const int half = task & 1, tok0 = (task >> 1) * 16, c0 = half * 512 + lane * 8, s0 = tok0 & (SEQ - 1);
        f32x4 wv[5][2];
#pragma unroll
        for (int j = 0; j < 5; ++j) { wv[j][0] = *(const f32x4*)(convw + j * 1024 + c0); wv[j][1] = *(const f32x4*)(convw + j * 1024 + c0 + 4); }
        const bf16_t* src = proj + (size_t)tok0 * PJ_LD + C_MQ + c0;
        u32x4 rr[20];
#pragma unroll
        for (int j = 0; j < 20; ++j) { const int s = s0 + j - 2; const int sc = s < 0 ? 0 : (s >= SEQ ? SEQ - 1 : s); const u32x4 v = *(const u32x4*)(src + (ptrdiff_t)(sc - s0) * PJ_LD); rr[j] = (s == sc) ? v : (u32x4){0u, 0u, 0u, 0u}; }
#pragma unroll
        for (int i = 0; i < 16; ++i) {
            f32x4 a0 = {0.f, 0.f, 0.f, 0.f}, a1 = {0.f, 0.f, 0.f, 0.f};
#pragma unroll
            for (int j = 0; j < 5; ++j) { const u32x4 rw = rr[i + j];
                a0 += wv[j][0] * (f32x4){bf_lo(rw.x), bf_hi(rw.x), bf_lo(rw.y), bf_hi(rw.y)}; a1 += wv[j][1] * (f32x4){bf_lo(rw.z), bf_hi(rw.z), bf_lo(rw.w), bf_hi(rw.w)}; }
            const f32x4 t0 = a0 * -1.4426950408889634f, t1 = a1 * -1.4426950408889634f; f32x4 e0, e1;
#pragma unroll
            for (int q = 0; q < 4; ++q) { e0[q] = __builtin_amdgcn_exp2f(t0[q]); e1[q] = __builtin_amdgcn_exp2f(t1[q]); }
            const f32x4 d0 = e0 + 1.0f, d1 = e1 + 1.0f; f32x4 s0_, s1_;
#pragma unroll
            for (int q = 0; q < 4; ++q) { s0_[q] = __builtin_amdgcn_rcpf(d0[q]); s1_[q] = __builtin_amdgcn_rcpf(d1[q]); }
            a0 = a0 * s0_; a1 = a1 * s1_;
            u32x4 o; o.x = cvt_pk_bf16(a0[0], a0[1]); o.y = cvt_pk_bf16(a0[2], a0[3]); o.z = cvt_pk_bf16(a1[0], a1[1]); o.w = cvt_pk_bf16(a1[2], a1[3]);
            *(u32x4*)(qkc + (size_t)(tok0 + i) * 1024 + c0) = o; }
    }
}


__device__ __forceinline__ void phase_gates(const Params& p, LAS unsigned char* lds, int gw, int NGW, int lane) {
    const bf16_t* xb = (const bf16_t*)(p.ws + WS_RB); const bf16_t* wg = (const bf16_t*)(p.ws + WS_WIN) + (size_t)4608 * 2048; float* gates = (float*)(p.ws + WS_GATES);
    const int fr = lane & 15, fq = lane >> 4;
    constexpr int WROW = 4096 + 16;
    __syncthreads();
    for (int i = threadIdx.x; i < 32 * 256; i += 512) { const int row = i >> 8, pc = i & 255; *(LAS u32x4*)(lds + row * WROW + pc * 16) = *(const u32x4*)(wg + (size_t)row * DM + pc * 8); }
    __syncthreads();
    for (int task = gw; task < NTOK / 16; task += NGW) {
        const int row0 = task * 16;
        const bf16_t* ap = xb + (size_t)(row0 + fr) * DM + fq * 8;
        const LAS unsigned char* b0p = lds + fr * WROW + fq * 16; const LAS unsigned char* b1p = b0p + 16 * WROW;
        f32x4 acc0 = {0.f, 0.f, 0.f, 0.f}, acc1 = {0.f, 0.f, 0.f, 0.f};
#pragma unroll 8
        for (int ks = 0; ks < 64; ++ks) { const bf16x8 a = *(const bf16x8*)(ap + ks * 32), b0 = *(const LAS bf16x8*)(b0p + ks * 64), b1 = *(const LAS bf16x8*)(b1p + ks * 64);
            acc0 = __builtin_amdgcn_mfma_f32_16x16x32_bf16(a, b0, acc0, 0, 0, 0); acc1 = __builtin_amdgcn_mfma_f32_16x16x32_bf16(a, b1, acc1, 0, 0, 0); }
#pragma unroll
        for (int r = 0; r < 4; ++r) { float* gp = gates + (size_t)(row0 + 4 * fq + r) * 32 + fr; gp[0] = acc0[r]; gp[16] = acc1[r]; }
    }
    __syncthreads();
}

__device__ __forceinline__ void phase_mlstm_naive(const Params& p, LAS unsigned char* lds) {
    const bf16_t* proj = (const bf16_t*)(p.ws + WS_RA); const float* gates = (const float*)(p.ws + WS_GATES); bf16_t* hdir = (bf16_t*)p.out;
    const float* convw = p.in[I_CONVW];
    LAS float* qs = (LAS float*)lds; LAS float* ks = qs + 4096; LAS float* vs = ks + 4096; LAS float* gi = vs + 8192; LAS float* gf = gi + 64;
    const int tid = threadIdx.x;
    for (int job = blockIdx.x; job < 256; job += gridDim.x) {
        const int dir = job & 1, h = (job >> 1) & 7, b = job >> 4;
        float C[64], n[64];
#pragma unroll
        for (int d = 0; d < 64; ++d) { C[d] = 0.f; n[d] = 0.f; }
        for (int ci = 0; ci < 32; ++ci) {
            const int t0 = (dir ? 31 - ci : ci) * 64;
            __syncthreads();
            for (int e = tid; e < 8192; e += 512) { const int which = e >> 12, tl = (e >> 6) & 63, c = e & 63, ch = which * 512 + h * 64 + c;
                float a = 0.f;
#pragma unroll
                for (int j = 0; j < 5; ++j) { const int tt = t0 + tl + j - 2; if (tt >= 0 && tt < SEQ) a += convw[j * 1024 + ch] * bf2f(proj[(size_t)(b * SEQ + tt) * PJ_LD + C_MQ + ch]); }
                const float v = siluf_(a);
                if (which == 0) qs[tl * 64 + c] = v * 0.125f; else ks[tl * 64 + c] = v; }
            for (int e = tid; e < 8192; e += 512) { const int tl = e >> 7, c = e & 127; vs[e] = bf2f(proj[(size_t)(b * SEQ + t0 + tl) * PJ_LD + C_MV + h * 128 + c]); }
            if (tid < 64) { const size_t tok = (size_t)b * SEQ + t0 + tid;
                const float gpi = gates[tok * 32 + dir * 16 + h] + p.in[I_BI][dir * 8 + h], gpf = gates[tok * 32 + dir * 16 + 8 + h] + p.in[I_BF][dir * 8 + h];
                gi[tid] = __expf(gpi); gf[tid] = 1.0f / (1.0f + __expf(-gpf)); }
            __syncthreads();
            if (tid < 128) {
                for (int r = 0; r < 64; ++r) { const int tl = dir ? 63 - r : r;
                    const float f = gf[tl], ig = gi[tl], vv = vs[tl * 128 + tid];
                    float num = 0.f, den = 0.f;
#pragma unroll
                    for (int d = 0; d < 64; ++d) { const float kd = ks[tl * 64 + d] * ig, qd = qs[tl * 64 + d];
                        n[d] = f * n[d] + kd; C[d] = f * C[d] + kd * vv; num += qd * C[d]; den += qd * n[d]; }
                    const float hv = num / fmaxf(fabsf(den), 1.0f);
                    hdir[((size_t)dir * NTOK + (size_t)b * SEQ + t0 + tl) * 1024 + h * 128 + tid] = (bf16_t)f2bf(hv); }
            }
        }
    }
}


namespace ml {
constexpr int LD = 72;
constexpr int LDV = 152;
constexpr int O_QS = 0, O_KS = 9216, O_SP = 18432, O_CT = 27648, O_VR = 48384, O_VEC = 67840;
__device__ __forceinline__ bf16x8 frag(const LAS unsigned char* lds, int arr, int row0, int ks, int lb) { return *(const LAS bf16x8*)(lds + (arr + row0 * (LD * 2) + ks * 64) + lb); }
__device__ __forceinline__ s16x4 trr(int addr) { s16x4 r; asm volatile("ds_read_b64_tr_b16 %0, %1" : "=&v"(r) : "v"(addr) : "memory"); return r; }
#define ML_PK(L, H) (bf16x8){L[0], L[1], L[2], L[3], H[0], H[1], H[2], H[3]}
#define ML_LGKM0() do { asm volatile("s_waitcnt lgkmcnt(0)" ::: "memory"); __builtin_amdgcn_sched_barrier(0); } while (0)
}
__device__ __forceinline__ void phase_mlstm(const Params& p, LAS unsigned char* lds) {
    using namespace ml;
    const bf16_t* proj = (const bf16_t*)(p.ws + WS_RA); const float* gates = (const float*)(p.ws + WS_GATES); bf16_t* hdir = (bf16_t*)p.out;
    const bf16_t* qkc = (const bf16_t*)(p.ws + WS_RE);
    LAS bf16_t* Qs = (LAS bf16_t*)(lds + O_QS); LAS bf16_t* Ks = (LAS bf16_t*)(lds + O_KS);
    LAS bf16_t* Sp = (LAS bf16_t*)(lds + O_SP); LAS bf16_t* CT = (LAS bf16_t*)(lds + O_CT); LAS bf16_t* Vr = (LAS bf16_t*)(lds + O_VR);
    LAS float* EB = (LAS float*)(lds + O_VEC); LAS float* EA = EB + 2048; LAS float* E63 = EA + 2048; LAS float* den = E63 + 32;
    const int tid = threadIdx.x, lane = tid & 63, wave = __builtin_amdgcn_readfirstlane(tid >> 6), fr = lane & 15, fq = lane >> 4;
    const int lds_base = (int)(unsigned)(__UINTPTR_TYPE__)lds;
    const int stok = tid >> 3, spc = tid & 7;
    for (int job = blockIdx.x; job < 256; job += gridDim.x) {
        const int dir = job & 1, h = (job >> 1) & 7, b = job >> 4;
        const float bi = p.in[I_BI][dir * 8 + h], bfg = p.in[I_BF][dir * 8 + h];
        __syncthreads();
#pragma unroll
        for (int k = 0; k < 4; ++k) { const int cj = wave + 8 * k, t0g = (dir ? 31 - cj : cj) * 64, tl = dir ? 63 - lane : lane; const size_t tok = (size_t)b * SEQ + t0g + tl;
            const float xf = gates[tok * 32 + dir * 16 + 8 + h] + bfg, xi = gates[tok * 32 + dir * 16 + h] + bi;
            const float lf = xf >= 0.f ? -log1pf(expf(-xf)) : xf - log1pf(expf(xf));
            float bc = lf;
#pragma unroll
            for (int o = 1; o < 64; o <<= 1) { const float t = __shfl_up(bc, o); if (lane >= o) bc += t; }
            EB[cj * 64 + lane] = expf(bc); EA[cj * 64 + lane] = expf(xi - bc); if (lane == 63) E63[cj] = expf(bc); }
        for (int i = tid; i < 144 * LD / 2; i += 512) ((LAS unsigned*)CT)[i] = 0u;
        for (int i = tid; i < 64 * 16; i += 512) Vr[(i >> 4) * LDV + 128 + (i & 15)] = (bf16_t)(((i & 15) == 0) ? 0x3F80 : 0);
        f32x4 Cacc[5];
#pragma unroll
        for (int i = 0; i < 5; ++i) Cacc[i] = (f32x4){0.f, 0.f, 0.f, 0.f};
        u32x4 rq, rk, va, vb_, rqn, rkn, van, vbn;
#define ML_LOAD(cidx, RQ, RK, VA, VB) do { const int t0n_ = (dir ? 31 - (cidx) : (cidx)) * 64; const size_t tk_ = (size_t)(b * SEQ + t0n_ + stok); \
            const bf16_t* qs_ = qkc + tk_ * 1024 + h * 64 + spc * 8; RQ = *(const u32x4*)qs_; RK = *(const u32x4*)(qs_ + 512); \
            const bf16_t* vs_ = proj + tk_ * PJ_LD + C_MV + h * 128 + spc * 16; VA = *(const u32x4*)vs_; VB = *(const u32x4*)(vs_ + 8); } while (0)
        ML_LOAD(0, rq, rk, va, vb_);
        __syncthreads();
        for (int ci = 0; ci < 32; ++ci) {
            const int t0 = (dir ? 31 - ci : ci) * 64;
            int lb = fr * (LD * 2) + fq * 16; asm volatile("" : "+v"(lb));
            int tk = lds_base + O_KS + (8 * fq + (fr >> 2)) * (LD * 2) + (fr & 3) * 8; asm volatile("" : "+v"(tk));
            int tv = lds_base + O_VR + (8 * fq + (fr >> 2)) * (LDV * 2) + (fr & 3) * 8; asm volatile("" : "+v"(tv));
            { const int cn = ci + 1 < 32 ? ci + 1 : ci; ML_LOAD(cn, rqn, rkn, van, vbn); }
            { const int r = dir ? 63 - stok : stok; const float sq = 0.125f * EB[ci * 64 + r], sk = EA[ci * 64 + r];
              const unsigned qw[4] = {rq.x, rq.y, rq.z, rq.w}, kw[4] = {rk.x, rk.y, rk.z, rk.w};
              u32x4 oq, ok;
              oq.x = cvt_pk_bf16(bf_lo(qw[0]) * sq, bf_hi(qw[0]) * sq); oq.y = cvt_pk_bf16(bf_lo(qw[1]) * sq, bf_hi(qw[1]) * sq); oq.z = cvt_pk_bf16(bf_lo(qw[2]) * sq, bf_hi(qw[2]) * sq); oq.w = cvt_pk_bf16(bf_lo(qw[3]) * sq, bf_hi(qw[3]) * sq);
              ok.x = cvt_pk_bf16(bf_lo(kw[0]) * sk, bf_hi(kw[0]) * sk); ok.y = cvt_pk_bf16(bf_lo(kw[1]) * sk, bf_hi(kw[1]) * sk); ok.z = cvt_pk_bf16(bf_lo(kw[2]) * sk, bf_hi(kw[2]) * sk); ok.w = cvt_pk_bf16(bf_lo(kw[3]) * sk, bf_hi(kw[3]) * sk);
              *(LAS u32x4*)(Qs + r * LD + spc * 8) = oq; *(LAS u32x4*)(Ks + r * LD + spc * 8) = ok;
              *(LAS u32x4*)(Vr + r * LDV + spc * 16) = va; *(LAS u32x4*)(Vr + r * LDV + spc * 16 + 8) = vb_; }
            __syncthreads();
#pragma unroll
            for (int q = 0; q < 2; ++q) { const int idx = 2 * wave + q, st = idx >> 2, tt = idx & 3;
                f32x4 d = {0.f, 0.f, 0.f, 0.f};
                if (st <= tt) {
#pragma unroll
                    for (int ks = 0; ks < 2; ++ks) d = __builtin_amdgcn_mfma_f32_16x16x32_bf16(frag(lds, O_KS, st * 16, ks, lb), frag(lds, O_QS, tt * 16, ks, lb), d, 0, 0, 0);
                    if (st == tt) {
#pragma unroll
                        for (int rg_ = 0; rg_ < 4; ++rg_) if (4 * fq + rg_ > fr) d[rg_] = 0.f; } }
                u32x2 w; w.x = cvt_pk_bf16(d[0], d[1]); w.y = cvt_pk_bf16(d[2], d[3]);
                *(LAS u32x2*)(Sp + (tt * 16 + fr) * LD + st * 16 + 4 * fq) = w; }
            __syncthreads();
            f32x4 nacc[5];
            { const int tt = wave & 3, ka_ = tk + tt * 32;
              const bf16x8 s0 = frag(lds, O_SP, tt * 16, 0, lb), s1 = frag(lds, O_SP, tt * 16, 1, lb), q0 = frag(lds, O_QS, tt * 16, 0, lb), q1 = frag(lds, O_QS, tt * 16, 1, lb);
              const s16x4 kl0 = trr(ka_), kh0 = trr(ka_ + 4 * LD * 2), kl1 = trr(ka_ + 32 * LD * 2), kh1 = trr(ka_ + 36 * LD * 2);
              s16x4 vl0[5], vh0[5], vl1[5], vh1[5]; bf16x8 c0[5], c1[5];
#pragma unroll
              for (int i = 0; i < 5; ++i) { if (i < 4 || wave < 4) { const int vt = (wave + 8 * i) >> 2, va_ = tv + vt * 32;
                  vl0[i] = trr(va_); vh0[i] = trr(va_ + 4 * LDV * 2); vl1[i] = trr(va_ + 32 * LDV * 2); vh1[i] = trr(va_ + 36 * LDV * 2);
                  c0[i] = frag(lds, O_CT, vt * 16, 0, lb); c1[i] = frag(lds, O_CT, vt * 16, 1, lb); } }
              ML_LGKM0();
              const bf16x8 ka0 = ML_PK(kl0, kh0), ka1 = ML_PK(kl1, kh1);
              const float e63 = E63[ci];
#pragma unroll
              for (int i = 0; i < 5; ++i) { if (i < 4 || wave < 4) nacc[i] = __builtin_amdgcn_mfma_f32_16x16x32_bf16(ML_PK(vl0[i], vh0[i]), s0, (f32x4){0.f, 0.f, 0.f, 0.f}, 0, 0, 0); }
#pragma unroll
              for (int i = 0; i < 5; ++i) { if (i < 4 || wave < 4) nacc[i] = __builtin_amdgcn_mfma_f32_16x16x32_bf16(ML_PK(vl1[i], vh1[i]), s1, nacc[i], 0, 0, 0); }
#pragma unroll
              for (int i = 0; i < 5; ++i) { if (i < 4 || wave < 4) nacc[i] = __builtin_amdgcn_mfma_f32_16x16x32_bf16(c0[i], q0, nacc[i], 0, 0, 0); }
#pragma unroll
              for (int i = 0; i < 5; ++i) { if (i < 4 || wave < 4) nacc[i] = __builtin_amdgcn_mfma_f32_16x16x32_bf16(c1[i], q1, nacc[i], 0, 0, 0); }
#pragma unroll
              for (int i = 0; i < 5; ++i) { if (i < 4 || wave < 4) Cacc[i] = __builtin_amdgcn_mfma_f32_16x16x32_bf16(ka0, ML_PK(vl0[i], vh0[i]), Cacc[i], 0, 0, 0); }
#pragma unroll
              for (int i = 0; i < 5; ++i) { if (i < 4 || wave < 4) Cacc[i] = __builtin_amdgcn_mfma_f32_16x16x32_bf16(ka1, ML_PK(vl1[i], vh1[i]), Cacc[i], 0, 0, 0); }
#pragma unroll
              for (int i = 0; i < 5; ++i) { if (i < 4 || wave < 4) Cacc[i] = Cacc[i] * e63; }
            }
            if (wave < 4 && fq == 0) den[wave * 16 + fr] = nacc[4][0];
            __syncthreads();
#pragma unroll
            for (int i = 0; i < 4; ++i) { const int idx = wave + 8 * i, vt = idx >> 2, tt = idx & 3, t = tt * 16 + fr, tl = dir ? 63 - t : t;
                const float sc = __builtin_amdgcn_rcpf(fmaxf(fabsf(den[t]), 1.0f));
                u32x2 w; w.x = cvt_pk_bf16(nacc[i][0] * sc, nacc[i][1] * sc); w.y = cvt_pk_bf16(nacc[i][2] * sc, nacc[i][3] * sc);
                *(u32x2*)(hdir + ((size_t)dir * NTOK + (size_t)b * SEQ + t0 + tl) * 1024 + h * 128 + vt * 16 + 4 * fq) = w; }
#pragma unroll
            for (int i = 0; i < 5; ++i) { if (i < 4 || wave < 4) { const int idx = wave + 8 * i, vt = idx >> 2, dt = idx & 3;
                u32x2 w; w.x = cvt_pk_bf16(Cacc[i][0], Cacc[i][1]); w.y = cvt_pk_bf16(Cacc[i][2], Cacc[i][3]);
                *(LAS u32x2*)(CT + (vt * 16 + fr) * LD + dt * 16 + 4 * fq) = w; } }
            rq = rqn; rk = rkn; va = van; vb_ = vbn;
        }
#undef ML_LOAD
    }
    __syncthreads();
}


__device__ __forceinline__ void combine_unit(const Params& p, int tok0, int h, int wave, int lane) {
    const bf16_t* proj = (const bf16_t*)(p.ws + WS_RA); const bf16_t* hdir = (const bf16_t*)p.out; bf16_t* hcat = (bf16_t*)(p.ws + WS_RC);
    int lane_ = lane; asm volatile("" : "+v"(lane_));
    const int grp = lane_ >> 4, li = lane_ & 15;
    const f32x4 g0 = *(const f32x4*)(p.in[I_GM] + h * 128 + li * 8), g1 = *(const f32x4*)(p.in[I_GM] + h * 128 + li * 8 + 4);
    const float g[8] = {g0[0], g0[1], g0[2], g0[3], g1[0], g1[1], g1[2], g1[3]};
#pragma unroll
    for (int half = 0; half < 2; ++half) {
        u32x4 a[4], bb[4], ow[4];
#pragma unroll
        for (int u = 0; u < 4; ++u) { const int tok = tok0 + wave * 32 + (half * 4 + u) * 4 + grp;
            a[u] = __builtin_nontemporal_load((const u32x4*)(hdir + (size_t)tok * 1024 + h * 128 + li * 8)); bb[u] = __builtin_nontemporal_load((const u32x4*)(hdir + ((size_t)NTOK + tok) * 1024 + h * 128 + li * 8));
            ow[u] = __builtin_nontemporal_load((const u32x4*)(proj + (size_t)tok * PJ_LD + C_MO + h * 128 + li * 8)); }
#pragma unroll
        for (int u = 0; u < 4; ++u) { const int tok = tok0 + wave * 32 + (half * 4 + u) * 4 + grp;
            const float s_[8] = {bf_lo(a[u].x) + bf_lo(bb[u].x), bf_hi(a[u].x) + bf_hi(bb[u].x), bf_lo(a[u].y) + bf_lo(bb[u].y), bf_hi(a[u].y) + bf_hi(bb[u].y), bf_lo(a[u].z) + bf_lo(bb[u].z), bf_hi(a[u].z) + bf_hi(bb[u].z), bf_lo(a[u].w) + bf_lo(bb[u].w), bf_hi(a[u].w) + bf_hi(bb[u].w)};
            const float og[8] = {bf_lo(ow[u].x), bf_hi(ow[u].x), bf_lo(ow[u].y), bf_hi(ow[u].y), bf_lo(ow[u].z), bf_hi(ow[u].z), bf_lo(ow[u].w), bf_hi(ow[u].w)};
            float ss = 0.f;
#pragma unroll
            for (int j = 0; j < 8; ++j) ss += s_[j] * s_[j];
            ss = row_sum16(ss);
            const float r = rsqrtf(ss * (1.0f / 128.0f) + NORM_EPS);
            float o[8];
#pragma unroll
            for (int j = 0; j < 8; ++j) o[j] = sigmoidf_(og[j]) * (s_[j] * r * g[j]);
            u32x4 w; w.x = cvt_pk_bf16(o[0], o[1]); w.y = cvt_pk_bf16(o[2], o[3]); w.z = cvt_pk_bf16(o[4], o[5]); w.w = cvt_pk_bf16(o[6], o[7]);
            *(u32x4*)(hcat + (size_t)tok * DM + h * 128 + li * 8) = w; }
    }
}

__device__ __forceinline__ bool attn_unit(int i, int G, int c, int& b, int& hq, int& qb) {
    if (G == 256) { if (i >= 4) return false; const int x = c & 7, w = c >> 3; b = 4 * i + (x >> 1); hq = (x & 1) * 4 + (w >> 3); qb = w & 7; return true; }
    const int u = i * G + c; if (u >= 1024) return false; qb = u & 7; hq = (u >> 3) & 7; b = u >> 6; return true;
}
#define XB_TMO      128
#define XB_XCNT(j)  (256  + 64 * (j))
#define XB_XSUB(j)  (1280 + 64 * (j))
#define XB_XGEN(j)  (2304 + 64 * (j))
#define XB_TOP      3328
#define XB_TOPGEN   3392
#define XCD_BAR_WORDS 3456
#define XB_SPIN_CAP (1u << 18)
__device__ __forceinline__ unsigned xb_ld(unsigned* p)              { return __hip_atomic_load(p, __ATOMIC_RELAXED, __HIP_MEMORY_SCOPE_AGENT); }
__device__ __forceinline__ unsigned xb_add(unsigned* p, unsigned v) { return __hip_atomic_fetch_add(p, v, __ATOMIC_RELAXED, __HIP_MEMORY_SCOPE_AGENT); }
__device__ __forceinline__ unsigned xb_xcc_id() { return (unsigned)__builtin_amdgcn_s_getreg((3 << 11) | 20) & 0xFu; }
#define XB_SPIN(cond, bar) do { unsigned _sp = 0; while (cond) { __builtin_amdgcn_s_sleep(1); \
    if ((++_sp & 255u) == 0u) { if (xb_ld(&(bar)[XB_TMO])) break; if (_sp > XB_SPIN_CAP) { atomicAdd(&(bar)[XB_TMO], 1u); break; } } } } while (0)
constexpr int CTL_MLSTM_DONE = 12288;
__device__ __forceinline__ void phase_attention(const Params& p, unsigned char* lds_generic) {
    const bf16_t* proj = (const bf16_t*)(p.ws + WS_RA); bf16_t* hcat = (bf16_t*)(p.ws + WS_RC);
    int nunits = 0; { int b, hq, qb; while (attn_unit(nunits, gridDim.x, blockIdx.x, b, hq, qb)) ++nunits; }
    const int slot_pos = (gridDim.x == 256) ? (int)((blockIdx.x >> 3) & 3) + 1 : (nunits > 1 ? 1 : nunits);
    for (int i = 0; i <= nunits; ++i) {
        if (i == slot_pos) {
            { const int wv = __builtin_amdgcn_readfirstlane(threadIdx.x >> 6); __syncthreads();
              if (wv < 4) tr_loop(p, (LAS unsigned char*)lds_generic + wv * (2 * TR_BUF), threadIdx.x & 63, TR_SMALL + blockIdx.x * 4 + wv, TR_ALL, gridDim.x * 4);
              else {
                  if ((threadIdx.x & 63) == 0) { unsigned* ctl = (unsigned*)(p.ws + WS_CTL); XB_SPIN(xb_ld(ctl + CTL_MLSTM_DONE) < gridDim.x, ctl + 4096); }
                  __builtin_amdgcn_fence(__ATOMIC_ACQUIRE, "agent"); asm volatile("s_waitcnt vmcnt(0)" ::: "memory");
                  for (int j = 0;; ++j) { int b, hq, qb; if (!attn_unit(j, gridDim.x, blockIdx.x, b, hq, qb)) break;
                      combine_unit(p, b * SEQ + qb * 256, hq, (wv - 4) * 2, threadIdx.x & 63); combine_unit(p, b * SEQ + qb * 256, hq, (wv - 4) * 2 + 1, threadIdx.x & 63); } }
              __syncthreads(); }
        }
        if (i < nunits) { int b, hq, qb; int ii = i; asm volatile("" : "+s"(ii)); attn_unit(ii, gridDim.x, blockIdx.x, b, hq, qb);
          const int kvh = hq >> 2;
          const bf16_t* Qb = proj + (size_t)(b * SEQ + qb * 256) * PJ_LD + C_AQ + hq * 128;
          const bf16_t* Kh = proj + (size_t)(b * SEQ) * PJ_LD + C_AK + kvh * 128;
          const bf16_t* Vh = proj + (size_t)(b * SEQ) * PJ_LD + C_AV + kvh * 128;
          bf16_t* Ob = hcat + (size_t)(b * SEQ + qb * 256) * DM + 1024 + hq * 128;
          att::attn_dense_body(Qb, Kh, Vh, Ob, SEQ, (char*)lds_generic, p.in[I_GQ], (const float*)(p.ws + WS_ROPE), qb * 256); }
    }
}
__device__ __forceinline__ void phase_combine(const Params& p, int gw, int NGW, int lane) {
    const bf16_t* proj = (const bf16_t*)(p.ws + WS_RA); const bf16_t* hdir = (const bf16_t*)p.out; bf16_t* hcat = (bf16_t*)(p.ws + WS_RC);
    const int grp = lane >> 4, li = lane & 15;
    constexpr int NIT = NTOK * 8 / 4;
    static_assert(NIT % (4 * 2048) == 0, "combine batches assume a 256 x 8-wave grid");
    for (int it0 = gw; it0 < NIT; it0 += 4 * NGW) {
        u32x4 a[4], bb[4], ow[4];
#pragma unroll
        for (int u = 0; u < 4; ++u) { const int pair = (it0 + u * NGW) * 4 + grp, tok = pair >> 3, h = pair & 7;
            a[u] = *(const u32x4*)(hdir + (size_t)tok * 1024 + h * 128 + li * 8); bb[u] = *(const u32x4*)(hdir + ((size_t)NTOK + tok) * 1024 + h * 128 + li * 8);
            ow[u] = *(const u32x4*)(proj + (size_t)tok * PJ_LD + C_MO + h * 128 + li * 8); }
#pragma unroll
        for (int u = 0; u < 4; ++u) { const int pair = (it0 + u * NGW) * 4 + grp, tok = pair >> 3, h = pair & 7;
            float s[8] = {bf_lo(a[u].x) + bf_lo(bb[u].x), bf_hi(a[u].x) + bf_hi(bb[u].x), bf_lo(a[u].y) + bf_lo(bb[u].y), bf_hi(a[u].y) + bf_hi(bb[u].y), bf_lo(a[u].z) + bf_lo(bb[u].z), bf_hi(a[u].z) + bf_hi(bb[u].z), bf_lo(a[u].w) + bf_lo(bb[u].w), bf_hi(a[u].w) + bf_hi(bb[u].w)};
            const float og[8] = {bf_lo(ow[u].x), bf_hi(ow[u].x), bf_lo(ow[u].y), bf_hi(ow[u].y), bf_lo(ow[u].z), bf_hi(ow[u].z), bf_lo(ow[u].w), bf_hi(ow[u].w)};
            float ss = 0.f;
#pragma unroll
            for (int j = 0; j < 8; ++j) ss += s[j] * s[j];
            ss = row_sum16(ss);
            const float r = rsqrtf(ss * (1.0f / 128.0f) + NORM_EPS);
            const float* g = p.in[I_GM] + h * 128 + li * 8;
            float o[8];
#pragma unroll
            for (int j = 0; j < 8; ++j) o[j] = sigmoidf_(og[j]) * (s[j] * r * g[j]);
            u32x4 w; w.x = cvt_pk_bf16(o[0], o[1]); w.y = cvt_pk_bf16(o[2], o[3]); w.z = cvt_pk_bf16(o[4], o[5]); w.w = cvt_pk_bf16(o[6], o[7]);
            *(u32x4*)(hcat + (size_t)tok * DM + h * 128 + li * 8) = w; }
    }
}

__device__ __forceinline__ void phase_ln1_router(const Params& p, LAS unsigned char* lds, int gw, int NGW, int lane) {
    const bf16_t* y1b = (const bf16_t*)p.out;
    bf16_t* x1b = (bf16_t*)(p.ws + WS_RB); const float* wrt = (const float*)(p.ws + WS_WRT); float* aff = (float*)(p.ws + WS_AFF);
    unsigned char* x1f8 = p.ws + WS_RA;
    const float* g1 = p.in[I_LN1G]; const float* b1 = p.in[I_LN1B];
    constexpr int WROW = 4096 + 16;
    const int fr = lane & 15, fq = lane >> 4;
    __syncthreads();
    for (int i = threadIdx.x; i < 16 * 256; i += 512) { const int row = i >> 8, pc = i & 255; const f32x4 a = *(const f32x4*)(wrt + row * 2048 + pc * 8), c = *(const f32x4*)(wrt + row * 2048 + pc * 8 + 4);
        u32x4 w; w.x = cvt_pk_bf16(a[0], a[1]); w.y = cvt_pk_bf16(a[2], a[3]); w.z = cvt_pk_bf16(c[0], c[1]); w.w = cvt_pk_bf16(c[2], c[3]); *(LAS u32x4*)(lds + row * WROW + pc * 16) = w; }
    __syncthreads();
    for (int rg = gw; rg < NTOK / 16; rg += NGW) {
        const int row0 = rg * 16;
        u32x4 raw[4], rawa[4], rawb[4];
#pragma unroll
        for (int j = 0; j < 4; ++j) { raw[j] = __builtin_nontemporal_load((const u32x4*)(y1b + (size_t)row0 * DM + 8 * lane + 512 * j));
            rawa[j] = __builtin_nontemporal_load((const u32x4*)(y1b + (size_t)(row0 + 1) * DM + 8 * lane + 512 * j)); rawb[j] = __builtin_nontemporal_load((const u32x4*)(y1b + (size_t)(row0 + 2) * DM + 8 * lane + 512 * j)); }
        f32x4 gav[4], gbv[4], bav[4], bbv[4];
#pragma unroll
        for (int j = 0; j < 4; ++j) { gav[j] = *(const f32x4*)(g1 + 8 * lane + 512 * j); gbv[j] = *(const f32x4*)(g1 + 8 * lane + 512 * j + 4); bav[j] = *(const f32x4*)(b1 + 8 * lane + 512 * j); bbv[j] = *(const f32x4*)(b1 + 8 * lane + 512 * j + 4); }
        for (int r = 0; r < 16; ++r) {
            const int rn = r < 13 ? r + 3 : 15;
            u32x4 rawn[4];
#pragma unroll
            for (int j = 0; j < 4; ++j) rawn[j] = __builtin_nontemporal_load((const u32x4*)(y1b + (size_t)(row0 + rn) * DM + 8 * lane + 512 * j));
            f32x4 xa[4], xb_[4];
#pragma unroll
            for (int j = 0; j < 4; ++j) { xa[j] = (f32x4){bf_lo(raw[j].x), bf_hi(raw[j].x), bf_lo(raw[j].y), bf_hi(raw[j].y)}; xb_[j] = (f32x4){bf_lo(raw[j].z), bf_hi(raw[j].z), bf_lo(raw[j].w), bf_hi(raw[j].w)}; }
            f32x4 sv_ = (xa[0] + xb_[0]) + (xa[1] + xb_[1]) + ((xa[2] + xb_[2]) + (xa[3] + xb_[3]));
            const float mean = wave_sum((sv_[0] + sv_[1]) + (sv_[2] + sv_[3])) * (1.0f / DM);
            f32x4 qv_ = {0.f, 0.f, 0.f, 0.f};
#pragma unroll
            for (int j = 0; j < 4; ++j) { xa[j] = xa[j] - mean; xb_[j] = xb_[j] - mean; qv_ += xa[j] * xa[j]; qv_ += xb_[j] * xb_[j]; }
            const float rstd = rsqrtf(wave_sum((qv_[0] + qv_[1]) + (qv_[2] + qv_[3])) * (1.0f / DM) + NORM_EPS);
#pragma unroll
            for (int j = 0; j < 4; ++j) { const f32x4 oa = xa[j] * (gav[j] * rstd) + bav[j], ob = xb_[j] * (gbv[j] * rstd) + bbv[j];
                u32x4 w; w.x = cvt_pk_bf16(oa[0], oa[1]); w.y = cvt_pk_bf16(oa[2], oa[3]); w.z = cvt_pk_bf16(ob[0], ob[1]); w.w = cvt_pk_bf16(ob[2], ob[3]);
                *(u32x4*)(x1b + (size_t)(row0 + r) * DM + 8 * lane + 512 * j) = w;
                const f32x4 oa8 = oa * 8.f, ob8 = ob * 8.f;
                u32x2 w8; w8.x = pk4_fp8(oa8[0], oa8[1], oa8[2], oa8[3]); w8.y = pk4_fp8(ob8[0], ob8[1], ob8[2], ob8[3]);
                *(u32x2*)(x1f8 + (size_t)(row0 + r) * DM + 8 * lane + 512 * j) = w8; }
#pragma unroll
            for (int j = 0; j < 4; ++j) { raw[j] = rawa[j]; rawa[j] = rawb[j]; rawb[j] = rawn[j]; }
        }
        __threadfence_block(); VM_WAIT();
        f32x4 acc = {0.f, 0.f, 0.f, 0.f};
        const bf16_t* ap = x1b + (size_t)(row0 + fr) * DM + fq * 8; const LAS unsigned char* bp = lds + fr * WROW + fq * 16;
#pragma unroll 8
        for (int ks = 0; ks < 64; ++ks) { const bf16x8 a = *(const bf16x8*)(ap + ks * 32), bw = *(const LAS bf16x8*)(bp + ks * 64);
            acc = __builtin_amdgcn_mfma_f32_16x16x32_bf16(a, bw, acc, 0, 0, 0); }
        f32x4 av;
#pragma unroll
        for (int rgi = 0; rgi < 4; ++rgi) { float x = acc[rgi], mx = x;
            mx = row_max16(mx);
            const float e = __expf(x - mx); float sm = e;
            sm = row_sum16(sm);
            av[rgi] = e / sm; }
        const int b = row0 >> 11, s0 = row0 & (SEQ - 1);
        *(f32x4*)(aff + ((size_t)(b * 16 + fr)) * SEQ + s0 + 4 * fq) = av;
    }
    __syncthreads();
}

__device__ __forceinline__ void phase_topk(const Params& p, LAS unsigned char* lds) {
    const float* aff = (const float*)(p.ws + WS_AFF); int* gidx = (int*)(p.ws + WS_IDX); float* gatev = (float*)(p.ws + WS_GATEV); int* slot_of = (int*)(p.ws + WS_SLOT);
    LAS unsigned* hist = (LAS unsigned*)lds; LAS unsigned* wsum = hist + 256; LAS unsigned* misc = wsum + 16;
    const int tid = threadIdx.x, lane = tid & 63, wave = tid >> 6;
    for (int job = blockIdx.x; job < 256; job += gridDim.x) {
        const u32x4 vv = *(const u32x4*)(aff + (size_t)job * SEQ + tid * 4);
        const unsigned v[4] = {vv.x, vv.y, vv.z, vv.w};
        __syncthreads();
        if (tid == 0) { misc[0] = 0u; misc[1] = 256u; }
        for (int pass = 3; pass >= 0; --pass) {
            const int shift = pass * 8;
            if (tid < 256) hist[tid] = 0u;
            __syncthreads();
            const unsigned prefix = misc[0], kleft = misc[1];
            const unsigned mask_hi = pass == 3 ? 0u : (0xFFFFFFFFu << (shift + 8));
#pragma unroll
            for (int j = 0; j < 4; ++j) if ((v[j] & mask_hi) == prefix) atomicAdd((unsigned*)&hist[(v[j] >> shift) & 255u], 1u);
            __syncthreads();
            unsigned cnt = 0u, x = 0u;
            if (tid < 256) { cnt = hist[tid]; x = cnt;
#pragma unroll
                for (int o = 1; o < 64; o <<= 1) { const unsigned t = __shfl_down(x, o); if (lane + o < 64) x += t; }
                if (lane == 0) wsum[wave] = x; }
            __syncthreads();
            if (tid < 256) { unsigned above_waves = 0u; for (int w = wave + 1; w < 4; ++w) above_waves += wsum[w];
                const unsigned incl = x + above_waves, above = incl - cnt;
                if (above < kleft && kleft <= incl) { misc[0] = prefix | ((unsigned)tid << shift); misc[1] = kleft - above; } }
            __syncthreads();
        }
        const unsigned thr = misc[0], need_eq = misc[1];
        unsigned cg_ = 0u, ce_ = 0u;
#pragma unroll
        for (int j = 0; j < 4; ++j) { cg_ += v[j] > thr; ce_ += v[j] == thr; }
        unsigned val = cg_ | (ce_ << 16), incl = val;
#pragma unroll
        for (int o = 1; o < 64; o <<= 1) { const unsigned t = __shfl_up(incl, o); if (lane >= o) incl += t; }
        if (lane == 63) wsum[8 + wave] = incl;
        __syncthreads();
        unsigned base = incl - val; for (int w = 0; w < wave; ++w) base += wsum[8 + w];
        unsigned gt_before = base & 0xffffu, eq_before = base >> 16;
        const int b = job >> 4, e = job & 15;
#pragma unroll
        for (int j = 0; j < 4; ++j) { const int s = tid * 4 + j; const bool isgt = v[j] > thr, iseq = v[j] == thr;
            const bool sel = isgt || (iseq && eq_before < need_eq);
            const unsigned slot = gt_before + (eq_before < need_eq ? eq_before : need_eq);
            if (sel) { gidx[job * 256 + slot] = b * SEQ + s; gatev[job * 256 + slot] = __uint_as_float(v[j]); }
            slot_of[(size_t)(b * SEQ + s) * 16 + e] = sel ? (int)slot : -1;
            gt_before += isgt; eq_before += iseq; }
        __syncthreads();
    }
}

__device__ __forceinline__ void phase_final(float* y, unsigned char* ws_, const float* g2, const float* b2, int row_lo, int row_hi, int gw, int NGW, int lane_in) {
    int lane = lane_in; asm volatile("" : "+v"(lane));
    const bf16_t* x1b = (const bf16_t*)(ws_ + WS_RB); const bf16_t* pl = (const bf16_t*)(ws_ + WS_RE); const unsigned char* ymoe = ws_ + WS_RA  ; const int* slot_of = (const int*)(ws_ + WS_SLOT);
    const int r0 = row_lo + gw;
    if (r0 >= row_hi) return;
    u32x2 xw[8], pw[8]; int sv;
#pragma unroll
    for (int j = 0; j < 8; ++j) { xw[j] = __builtin_nontemporal_load((const u32x2*)(x1b + (size_t)r0 * DM + 4 * lane + 256 * j)); pw[j] = __builtin_nontemporal_load((const u32x2*)(pl + (size_t)r0 * DM + 4 * lane + 256 * j)); }
    sv = slot_of[(size_t)r0 * 16 + (lane & 15)];
    for (int row = r0; row < row_hi; row += NGW) {
        const int b = row >> 11;
        unsigned long long bm = __ballot(lane < 16 && sv >= 0); unsigned m = (unsigned)bm & 0xffffu;
        const int cnt = __builtin_popcount(m);
        unsigned ym[4][8];
#pragma unroll
        for (int k = 0; k < 4; ++k) { if (k < cnt) { const int e = __builtin_ctz(m); m &= m - 1u; const int sl = __builtin_amdgcn_readlane(sv, e);
                const unsigned char* yr2 = ymoe + ((size_t)(b * 16 + e) * CAP + sl) * DM;
#pragma unroll
                for (int j = 0; j < 8; ++j) ym[k][j] = __builtin_nontemporal_load((const unsigned*)(yr2 + 4 * lane + 256 * j)); } }
        const int rn = row + NGW < row_hi ? row + NGW : row;
        u32x2 xn[8], pn[8];
#pragma unroll
        for (int j = 0; j < 8; ++j) { xn[j] = __builtin_nontemporal_load((const u32x2*)(x1b + (size_t)rn * DM + 4 * lane + 256 * j)); pn[j] = __builtin_nontemporal_load((const u32x2*)(pl + (size_t)rn * DM + 4 * lane + 256 * j)); }
        const int svn = slot_of[(size_t)rn * 16 + (lane & 15)];
        f32x4 v[8];
#pragma unroll
        for (int j = 0; j < 8; ++j) { v[j] = (f32x4){bf_lo(xw[j].x), bf_hi(xw[j].x), bf_lo(xw[j].y), bf_hi(xw[j].y)} * ALPHA;
            v[j][0] += bf_lo(pw[j].x); v[j][1] += bf_hi(pw[j].x); v[j][2] += bf_lo(pw[j].y); v[j][3] += bf_hi(pw[j].y); }
#pragma unroll
        for (int k = 0; k < 4; ++k) { if (k < cnt) {
#pragma unroll
                for (int j = 0; j < 8; ++j) { const auto lo_ = __builtin_amdgcn_cvt_pk_f32_fp8((int)ym[k][j], false), hi_ = __builtin_amdgcn_cvt_pk_f32_fp8((int)ym[k][j], true);
                    v[j][0] += lo_[0] * (1.0f / 64.0f); v[j][1] += lo_[1] * (1.0f / 64.0f); v[j][2] += hi_[0] * (1.0f / 64.0f); v[j][3] += hi_[1] * (1.0f / 64.0f); } } }
        while (m) { const int e = __builtin_ctz(m); m &= m - 1u; const int sl = __builtin_amdgcn_readlane(sv, e);
            const unsigned char* yr2 = ymoe + ((size_t)(b * 16 + e) * CAP + sl) * DM;
#pragma unroll
            for (int j = 0; j < 8; ++j) { const int w = *(const int*)(yr2 + 4 * lane + 256 * j); const auto lo_ = __builtin_amdgcn_cvt_pk_f32_fp8(w, false), hi_ = __builtin_amdgcn_cvt_pk_f32_fp8(w, true);
                v[j][0] += lo_[0] * (1.0f / 64.0f); v[j][1] += lo_[1] * (1.0f / 64.0f); v[j][2] += hi_[0] * (1.0f / 64.0f); v[j][3] += hi_[1] * (1.0f / 64.0f); } }
        float s = 0.f;
#pragma unroll
        for (int j = 0; j < 8; ++j) s += (v[j][0] + v[j][1]) + (v[j][2] + v[j][3]);
        const float mean = wave_sum(s) * (1.0f / DM); float s2 = 0.f;
#pragma unroll
        for (int j = 0; j < 8; ++j) { v[j] = v[j] - mean; s2 += (v[j][0] * v[j][0] + v[j][1] * v[j][1]) + (v[j][2] * v[j][2] + v[j][3] * v[j][3]); }
        const float rstd = rsqrtf(wave_sum(s2) * (1.0f / DM) + NORM_EPS);
        float* yr = y + (size_t)row * DM;
#pragma unroll
        for (int j = 0; j < 8; ++j) { const f32x4 gg = *(const f32x4*)(g2 + 4 * lane + 256 * j), bb = *(const f32x4*)(b2 + 4 * lane + 256 * j);
            __builtin_nontemporal_store(v[j] * rstd * gg + bb, (f32x4*)(yr + 4 * lane + 256 * j)); }
#pragma unroll
        for (int j = 0; j < 8; ++j) { xw[j] = xn[j]; pw[j] = pn[j]; }
        sv = svn;
    }
}

struct MoeOrderH {
    int G, c, half; float* fy; unsigned char* fws; const float* fg2; const float* fb2; int frow_lo, frow_hi;
    __device__ __forceinline__ bool next(int i, pg8::Unit& u) const {
        if (G == 256) { if (i >= 4) return false; const int x = c & 7, w = c >> 3, e = 4 * i + (x >> 1), b = half * 8 + 4 * (x & 1) + (w >> 3), j = w & 7; u.pm = b * 16 + e; u.pn = e * 8 + j; return true; }
        const long L = (long)i * G + c; if (L >= 1024) return false;
        const int pl_ = (int)(L >> 3), b = half * 8 + (pl_ >> 4), e = pl_ & 15; u.pm = b * 16 + e; u.pn = e * 8 + (int)(L & 7); return true;
    }
    __device__ __forceinline__ bool slot(int ui) const {
        if (frow_lo >= frow_hi) return false;
        if (ui != (G == 256 ? ((c >> 3) & 3) : 0)) return false;
        const int wv = __builtin_amdgcn_readfirstlane(threadIdx.x >> 6);
        phase_final(fy, fws, fg2, fb2, frow_lo, frow_hi, c * 8 + wv, G * 8, threadIdx.x & 63);
        return true;
    }
};

struct XcdBarrier { unsigned* bar; unsigned x; volatile LAS unsigned* st; };
__device__ __forceinline__ XcdBarrier xcd_barrier_post(unsigned* bar, volatile LAS unsigned* st) {
    XcdBarrier b; b.bar = bar; b.x = xb_xcc_id(); b.st = st;
    if (threadIdx.x == 0) (void)xb_add(&bar[XB_XCNT(b.x)], 1u);
    return b;
}
__device__ __forceinline__ void xcd_barrier_complete(unsigned* bar, unsigned x, unsigned& nloc, unsigned& nx) {
    const unsigned G = gridDim.x * gridDim.y * gridDim.z;
    unsigned sum, cnt, mine, sp = 0u;
    for (;;) {
        sum = 0u; cnt = 0u; mine = 0u;
#pragma unroll
        for (unsigned j = 0; j < 16; ++j) { const unsigned c = xb_ld(&bar[XB_XCNT(j)]); sum += c; cnt += (c > 0u) ? 1u : 0u; mine = (j == x) ? c : mine; }
        if (sum == G) break;
        __builtin_amdgcn_s_sleep(1);
        if ((++sp & 255u) == 0u) { if (xb_ld(&bar[XB_TMO])) break; if (sp > XB_SPIN_CAP) { atomicAdd(&bar[XB_TMO], 1u); break; } }
    }
    nloc = mine > 0u ? mine : 1u; nx = cnt > 0u ? cnt : 1u;
}
__device__ __forceinline__ void xcd_barrier(const XcdBarrier& b) {
    asm volatile("s_waitcnt vmcnt(0)" ::: "memory");
    __syncthreads();
    if (threadIdx.x == 0) {
        unsigned* bar = b.bar;
        __builtin_amdgcn_s_waitcnt(0);
        unsigned nloc = b.st[0], nx = b.st[1];
        if (nloc == 0u) { xcd_barrier_complete(bar, b.x, nloc, nx); b.st[0] = nloc; b.st[1] = nx; }
        const unsigned old = xb_add(&bar[XB_XSUB(b.x)], 1u);
        const unsigned gen = old / nloc;
        if (old + 1u == (gen + 1u) * nloc) {
            __builtin_amdgcn_fence(__ATOMIC_RELEASE, "agent");
            asm volatile("s_waitcnt vmcnt(0)" ::: "memory");
            const unsigned og = xb_add(&bar[XB_TOP], 1u);
            const unsigned tg = og / nx;
            if (og + 1u == (tg + 1u) * nx) xb_add(&bar[XB_TOPGEN], 1u);
            else XB_SPIN(xb_ld(&bar[XB_TOPGEN]) == tg, bar);
            __builtin_amdgcn_fence(__ATOMIC_ACQUIRE, "agent");
            xb_add(&bar[XB_XGEN(b.x)], 1u);
            asm volatile("s_waitcnt vmcnt(0)" ::: "memory");
        } else {
            XB_SPIN(xb_ld(&bar[XB_XGEN(b.x)]) == gen, bar);
            __builtin_amdgcn_fence(__ATOMIC_ACQUIRE, "agent");
            asm volatile("s_waitcnt vmcnt(0)" ::: "memory");
        }
    }
    __syncthreads();
}

__global__ void __launch_bounds__(512, 2) mk_fwd(Params parg) {
#if defined(__HIP_DEVICE_COMPILE__)
#define LOADP() const __attribute__((address_space(4))) Params* pk_ = (const __attribute__((address_space(4))) Params*)__builtin_amdgcn_kernarg_segment_ptr(); asm volatile("" : "+s"(pk_)); const Params p = *pk_; \
    int tl_ = threadIdx.x; asm volatile("" : "+v"(tl_)); const int lane = tl_ & 63
#else
#define LOADP() const Params p = parg; const int lane = threadIdx.x & 63
#endif
    extern __shared__ __attribute__((aligned(16))) unsigned char lds_raw[];
    LAS unsigned char* lds = (LAS unsigned char*)lds_raw;
    const int tid = threadIdx.x, wave = __builtin_amdgcn_readfirstlane(tid >> 6);
    const int G = gridDim.x, c = blockIdx.x;
    const int gw = c * 8 + wave, NGW = G * 8;
    unsigned char* ws = parg.ws;
    const int lo = parg.ph_lo, hi = parg.ph_hi;
#ifndef MK_MASK
#define MK_MASK 0x7ff
#endif
#define IN(k) (((MK_MASK >> (k)) & 1) && lo <= (k) && (k) < hi)
#if MK_ONE_LAUNCH
    volatile LAS unsigned* bst = (volatile LAS unsigned*)(lds + LDS_MISC);
    if (tid < 2) bst[tid] = 0u;
    __syncthreads();
    (void)xcd_barrier_post((unsigned*)(ws + WS_CTL) + 4096, bst);
#define xbar (XcdBarrier{(unsigned*)(ws + WS_CTL) + 4096, xb_xcc_id(), (volatile LAS unsigned*)(lds + LDS_MISC)})
#define SEAM(k) do { if (IN(k) && IN((k) + 1)) xcd_barrier(xbar); } while (0)
#else
#define SEAM(k) do { } while (0)
#endif
    if (IN(0)) { LOADP(); phase0(p, lds, gw, NGW, wave, lane); }
    SEAM(0);
    if (IN(1)) { LOADP(); pg8::StaticOrder S; S.init(NTOK, PJ_LD, G, c);
        pg8::EpiProj E{(bf16_t*)(ws + WS_RA), (float*)(ws + WS_GATES)};
        pg8::gemm_phase<pg8::EpiProj, pg8::StaticOrder, false>(lds, (const bf16_t*)(ws + WS_RB), (const bf16_t*)(ws + WS_WIN), 2048, S, E, nullptr); }
    SEAM(1);
    if (IN(2)) { LOADP(); phase_normrope(p, gw, NGW, lane); phase_convsilu(p, gw, NGW, lane); }
    SEAM(2);
    if (IN(3)) { LOADP();
#ifdef MK_MLSTM_NAIVE
        phase_mlstm_naive(p, lds);
#else
        phase_mlstm(p, lds);
#endif
        asm volatile("s_waitcnt vmcnt(0)" ::: "memory"); __syncthreads();
        if (threadIdx.x == 0) { __builtin_amdgcn_fence(__ATOMIC_RELEASE, "agent"); asm volatile("s_waitcnt vmcnt(0)" ::: "memory"); (void)xb_add((unsigned*)(ws + WS_CTL) + CTL_MLSTM_DONE, 1u); }
    }
    if (IN(4)) { LOADP(); phase_attention(p, lds_raw); }
    SEAM(4);
    if (IN(5)) { LOADP(); pg8::StaticOrder S; S.init(NTOK, DM, G, c); pg8::EpiOut E{(const bf16_t*)(ws + WS_RB), (bf16_t*)p.out};
        pg8::gemm_phase<pg8::EpiOut, pg8::StaticOrder, false>(lds, (const bf16_t*)(ws + WS_RC), (const bf16_t*)(ws + WS_WOUT), 2048, S, E, nullptr); }
    SEAM(5);
    if (IN(6)) { LOADP(); phase_ln1_router(p, lds, gw, NGW, lane); }
    SEAM(6);
    if (IN(7)) { LOADP(); phase_topk(p, lds); }
    SEAM(7);
    if (IN(8)) { LOADP();
        { pg8::MoeOrder S{G, c}; pg8::EpiGU E{ws + WS_RC};
          pg8::gemm_phase<pg8::EpiGU, pg8::MoeOrder, true, true>(lds, ws + WS_RA, ws + WS_WGU, 2048, S, E, (const int*)(ws + WS_IDX)); }
        { pg8::StaticOrder S; S.init(NTOK, DM, G, c); pg8::EpiPlain E{(bf16_t*)(ws + WS_RE)};
          pg8::gemm_phase<pg8::EpiPlain, pg8::StaticOrder, false>(lds, (const bf16_t*)(ws + WS_PB), (const bf16_t*)(ws + WS_WPP), 256, S, E, nullptr); }
        { pg8::StaticOrder S; S.init(NTOK, DM, G, c); pg8::EpiPlGate E{(bf16_t*)(ws + WS_RE), p.in[I_BPG]};
          pg8::gemm_phase<pg8::EpiPlGate, pg8::StaticOrder, false, true>(lds, ws + WS_RA, ws + WS_WPG, 2048, S, E, nullptr); }
    }
    SEAM(8);
    if (IN(9)) { LOADP();
        pg8::MoeOrder S{G, c}; pg8::EpiDown E{ws + WS_RA, (const float*)(ws + WS_GATEV)};
        pg8::gemm_phase<pg8::EpiDown, pg8::MoeOrder, false, true>(lds, ws + WS_RC, ws + WS_WDN, 1024, S, E, nullptr);
    }
    SEAM(9);
    if (IN(10)) { LOADP(); phase_final(p.out, ws, p.in[I_LN2G], p.in[I_LN2B], 0, NTOK, gw, NGW, lane); }
#undef IN
#undef SEAM
}

extern "C" void kernel_launch(void* const* d_in, const int* in_sizes, int n_in, void* d_out, int out_size, void* d_ws, size_t ws_size, hipStream_t stream) {
    static int grid = 0;
    if (grid == 0) {
        if (n_in != 21 || in_sizes[0] != NTOK * DM || out_size != NTOK * DM || ws_size < WS_END) {
            fprintf(stderr, "kernel_launch: shape mismatch: n_in %d in0 %d out %d ws %zu (need >= %zu)\n", n_in, n_in > 0 ? in_sizes[0] : -1, out_size, ws_size, (size_t)WS_END); grid = -1; return; }
        int dev = 0, cus = 0, per_cu = 0;
        if (hipGetDevice(&dev) != hipSuccess || hipDeviceGetAttribute(&cus, hipDeviceAttributeMultiprocessorCount, dev) != hipSuccess) { fprintf(stderr, "kernel_launch: device query failed\n"); grid = -1; return; }
        if (hipFuncSetAttribute((const void*)mk_fwd, hipFuncAttributeMaxDynamicSharedMemorySize, LDS_BYTES) != hipSuccess) { fprintf(stderr, "kernel_launch: hipFuncSetAttribute failed\n"); grid = -1; return; }
        if (hipOccupancyMaxActiveBlocksPerMultiprocessor(&per_cu, (const void*)mk_fwd, 512, LDS_BYTES) != hipSuccess || per_cu < 1) { fprintf(stderr, "kernel_launch: occupancy query says %d blocks per CU\n", per_cu); (void)hipGetLastError(); per_cu = 1; }
        grid = cus;
    }
    if (grid < 0) return;
    if (hipMemsetAsync((char*)d_ws + WS_CTL, 0, 65536, stream) != hipSuccess) { fprintf(stderr, "kernel_launch: memset of control words failed\n"); return; }
    Params p{};
    for (int i = 0; i < 21; ++i) p.in[i] = (const float*)d_in[i];
    p.out = (float*)d_out; p.ws = (unsigned char*)d_ws;
#if MK_ONE_LAUNCH
    p.ph_lo = 0; p.ph_hi = 11;
    void* args[] = {&p};
    hipError_t e = hipLaunchCooperativeKernel((const void*)mk_fwd, dim3(grid), dim3(512), args, LDS_BYTES, stream);
    if (e != hipSuccess) fprintf(stderr, "kernel_launch: cooperative launch failed: %s (grid %d)\n", hipGetErrorString(e), grid);
#else
#ifndef MK_SEQ
#define MK_SEQ 0,1,2,3,4,5,6,7,8,9,10
#endif
    static const int seq_[] = {MK_SEQ};
    for (int si = 0; si < (int)(sizeof(seq_) / sizeof(seq_[0])); ++si) {
        p.ph_lo = seq_[si]; p.ph_hi = seq_[si] + 1;
        hipLaunchKernelGGL(mk_fwd, dim3(grid), dim3(512), LDS_BYTES, stream, p);
    }
    const hipError_t le = hipPeekAtLastError();
    if (le != hipSuccess) fprintf(stderr, "kernel_launch: launch failed: %s\n", hipGetErrorName(le));
#endif
}
```

```cpp
#include <hip/hip_runtime.h>
#include <hip/hip_cooperative_groups.h>
#include <cstdio>
#include <cstdint>
namespace cg = cooperative_groups;

#ifndef MK_ONE_LAUNCH
#define MK_ONE_LAUNCH 1
#endif

#define LAS __attribute__((address_space(3)))
typedef unsigned short bf16_t;
typedef short bf16x8 __attribute__((ext_vector_type(8)));
typedef short s16x4 __attribute__((ext_vector_type(4)));
typedef float f32x4 __attribute__((ext_vector_type(4)));
typedef float f32x16 __attribute__((ext_vector_type(16)));
typedef unsigned u32x4 __attribute__((ext_vector_type(4)));
typedef unsigned u32x2 __attribute__((ext_vector_type(2)));
typedef int v8i_t __attribute__((ext_vector_type(8)));

constexpr int NB = 16, SEQ = 2048, DM = 2048, NTOK = NB * SEQ;
constexpr int PJ_LD = 4608;
constexpr int C_AQ = 0, C_AK = 1024, C_AV = 1280, C_MQ = 1536, C_MK = 2048, C_MV = 2560, C_MO = 3584;
constexpr int WIN_ROWS = 4864;
constexpr int NEXP = 16, CAP = 256, FF = 1024, NSLOT = NB * NEXP * CAP;
constexpr float ALPHA = 1.189207115002721f;
constexpr float NORM_EPS = 1e-6f;

constexpr size_t MiB = 1u << 20;
constexpr size_t WS_CTL = 0, WS_ROPE = 1 * MiB, WS_WRT = 1 * MiB + 65536;
constexpr size_t WS_WIN = 2 * MiB, WS_WOUT = 22 * MiB, WS_WPG = 30 * MiB, WS_WPP = 38 * MiB, WS_WGU = 40 * MiB, WS_WDN = 168 * MiB;
constexpr size_t WS_WOUT8 = WS_WPG + 4 * MiB;
constexpr size_t WS_PB = 232 * MiB, WS_GATES = 248 * MiB, WS_AFF = 252 * MiB, WS_IDX = 254 * MiB, WS_GATEV = 254 * MiB + 512 * 1024, WS_SLOT = 255 * MiB;
constexpr size_t WS_RA = 258 * MiB;
constexpr size_t WS_TG = WS_RA + 128 * MiB;
constexpr size_t WS_RB = 546 * MiB;
constexpr size_t WS_RC = 674 * MiB;
constexpr size_t WS_RE = 802 * MiB;
constexpr size_t WS_STATS = WS_RE + 64 * MiB;
constexpr size_t WS_WIN8 = 930 * MiB;
constexpr size_t WS_END = 936 * MiB;

constexpr int STAGE_BYTES = 131072;
constexpr int LDS_GIDX = STAGE_BYTES;
constexpr int LDS_MISC = LDS_GIDX + 8192;
constexpr int LDS_BYTES = 147456;

__device__ __forceinline__ unsigned f2bf(float f) { unsigned u = __builtin_bit_cast(unsigned, f); return (u + 0x7fffu + ((u >> 16) & 1u)) >> 16; }
__device__ __forceinline__ unsigned pk2(float lo, float hi) { return f2bf(lo) | (f2bf(hi) << 16); }
typedef __bf16 bf16x2v_ __attribute__((ext_vector_type(2)));
typedef float f32x2v_ __attribute__((ext_vector_type(2)));
__device__ __forceinline__ unsigned cvt_pk_bf16(float lo, float hi) { f32x2v_ f = {lo, hi}; bf16x2v_ h = __builtin_convertvector(f, bf16x2v_); return __builtin_bit_cast(unsigned, h); }
__device__ __forceinline__ unsigned pk4_fp8(float a, float b, float c, float d) { int w = 0; w = __builtin_amdgcn_cvt_pk_fp8_f32(a, b, w, false); w = __builtin_amdgcn_cvt_pk_fp8_f32(c, d, w, true); return (unsigned)w; }
__device__ __forceinline__ float bf_lo(unsigned w) { return __uint_as_float(w << 16); }
__device__ __forceinline__ float bf_hi(unsigned w) { return __uint_as_float(w & 0xffff0000u); }
__device__ __forceinline__ float bf2f(bf16_t b) { return __uint_as_float(((unsigned)b) << 16); }
__device__ __forceinline__ float sigmoidf_(float x) { return __builtin_amdgcn_rcpf(1.0f + __expf(-x)); }
__device__ __forceinline__ float siluf_(float x) { return x * __builtin_amdgcn_rcpf(1.0f + __expf(-x)); }
#define WS_DPP(v, ctrl) ((v) + __builtin_bit_cast(float, __builtin_amdgcn_update_dpp(0, __builtin_bit_cast(int, (v)), (ctrl), 0xf, 0xf, true)))
#define WS_DPPV(v, ctrl) __builtin_bit_cast(float, __builtin_amdgcn_update_dpp(0, __builtin_bit_cast(int, (v)), (ctrl), 0xf, 0xf, true))
__device__ __forceinline__ float row_sum16(float v) { v = WS_DPP(v, 0xB1); v = WS_DPP(v, 0x4E); v = WS_DPP(v, 0x141); v = WS_DPP(v, 0x140); return v; }
__device__ __forceinline__ float row_max16(float v) { v = fmaxf(v, WS_DPPV(v, 0xB1)); v = fmaxf(v, WS_DPPV(v, 0x4E)); v = fmaxf(v, WS_DPPV(v, 0x141)); v = fmaxf(v, WS_DPPV(v, 0x140)); return v; }
__device__ __forceinline__ float lane_xor4(float v, int lane) { const float up = WS_DPPV(v, 0x104), dn = WS_DPPV(v, 0x114); return (lane & 4) ? dn : up; }
__device__ __forceinline__ float wave_sum(float v) {
    v = WS_DPP(v, 0xB1); v = WS_DPP(v, 0x4E); v = WS_DPP(v, 0x141); v = WS_DPP(v, 0x140);
    const int vi = __builtin_bit_cast(int, v);
    const float r0 = __builtin_bit_cast(float, __builtin_amdgcn_readlane(vi, 0)), r1 = __builtin_bit_cast(float, __builtin_amdgcn_readlane(vi, 16));
    const float r2 = __builtin_bit_cast(float, __builtin_amdgcn_readlane(vi, 32)), r3 = __builtin_bit_cast(float, __builtin_amdgcn_readlane(vi, 48));
    return (r0 + r1) + (r2 + r3);
}
#define LDS_WAIT() asm volatile("s_waitcnt lgkmcnt(0)" ::: "memory")
#define VM_WAIT() asm volatile("s_waitcnt vmcnt(0)" ::: "memory")

struct Params {
    const float* in[21];
    float* out;
    unsigned char* ws;
    int ph_lo, ph_hi;
};
enum { I_X = 0, I_P, I_WIN, I_CONVW, I_BI, I_BF, I_GM, I_GQ, I_GK, I_WOUT, I_LN1G, I_LN1B, I_WR, I_WG, I_WU, I_WD, I_WPP, I_WPG, I_BPG, I_LN2G, I_LN2B };

namespace pg8 {
constexpr int BM = 256, BK = 64, HALF = 128, HTB = HALF * BK * 2, NXCD = 8, WGM = 8;
__device__ __forceinline__ int lds_byte(int r, int c) { const int st = (r >> 4) * 2 + (c >> 5), rr = r & 15, cc = c & 31, ob = rr * 64 + cc * 2; return st * 1024 + (ob ^ (((ob >> 9) & 1) << 5)); }
__device__ __forceinline__ void stage_rc(int b, int& R, int& C) { const int st = b / 1024, sb = b % 1024, swz = sb ^ (((sb >> 9) & 1) << 5); R = (st >> 1) * 16 + swz / 64; C = (st & 1) * 32 + (swz % 64) / 2; }
__device__ __forceinline__ int perm32(int rho) { const int n = rho >> 4, i = rho & 15; return 8 * (i >> 2) + 4 * n + (i & 3); }

struct Unit { int pm, pn; };
struct frag2_t { bf16x8 lo, hi; };

struct StaticOrder {
    int nM, nN, nwg, G, c;
    __device__ void init(int M, int N, int G_, int c_) { nM = M / BM; nN = N / BM; nwg = nM * nN; G = G_; c = c_; }
    __device__ bool next(int i, Unit& u) const {
        const long L = (long)i * G + c; if (L >= nwg) return false;
        int wgid = (int)L; { const int q = nwg / NXCD, r = nwg % NXCD, xcd = wgid % NXCD, off = wgid / NXCD; wgid = (xcd < r ? xcd * (q + 1) : r * (q + 1) + (xcd - r) * q) + off; }
        const int nig = WGM * nN, gid = wgid / nig, fm = gid * WGM, gsz = (nM - fm) < WGM ? (nM - fm) : WGM;
        u.pm = fm + ((wgid % nig) % gsz); u.pn = (wgid % nig) / gsz; return true;
    }
    __device__ __forceinline__ bool slot(int) const { return false; }
};
struct StaticOrderOff : StaticOrder { int off; __device__ bool next(int i, Unit& u) const { const bool ok = StaticOrder::next(i, u); u.pn += off; return ok; } };
struct MoeOrder {
    int G, c;
    __device__ bool next(int i, Unit& u) const {
        if (G == 256) { if (i >= 8) return false; const int x = c & 7, w = c >> 3, e = 2 * i + (x >> 2), b = 4 * (x & 3) + (w >> 3), j = w & 7; u.pm = b * 16 + e; u.pn = e * 8 + j; return true; }
        const long L = (long)i * G + c; if (L >= 2048) return false;
        u.pm = (int)(L >> 3); u.pn = (u.pm & 15) * 8 + (int)(L & 7); return true;
    }
    __device__ __forceinline__ bool slot(int) const { return false; }
};

struct StaticOrderRevM : StaticOrder { __device__ bool next(int i, Unit& u) const { const bool ok = StaticOrder::next(i, u); u.pm = nM - 1 - u.pm; return ok; } };
struct MoeOrderRev : MoeOrder { __device__ bool next(int i, Unit& u) const { if (G == 256) { if (i >= 8) return false; return MoeOrder::next(7 - i, u); } return MoeOrder::next(i, u); } };
template <class T, class = void> struct epi_preload { static constexpr bool value = false; };
template <class T> struct epi_preload<T, decltype((void)T::PRELOAD)> { static constexpr bool value = T::PRELOAD; };
template <class Epi, class Sched, bool GATHER, bool F8 = false>
__device__ __forceinline__ void gemm_phase(LAS unsigned char* lds, const void* A, const void* Bt, const int K, const Sched& S, const Epi& E, const int* rowidx) {
    int tid_ = threadIdx.x; asm volatile("" : "+v"(tid_));
    const int tid = tid_, wid = __builtin_amdgcn_readfirstlane(tid >> 6), lane = tid & 63, wr = wid >> 2, wc = wid & 3, fr = lane & 15, fq = lane >> 4;
    const int nt = F8 ? K / 128 : K / BK;
    const int RP = F8 ? K : 2 * K;
    unsigned voffB[1];
    { int R, C; stage_rc(tid * 16, R, C); const int Rb = Epi::PERM ? ((R & ~31) + perm32(R & 31)) : R; voffB[0] = (unsigned)(Rb * RP + C * 2); }
    const size_t kstep = (size_t)(BK * 2);
    const size_t hstep = (size_t)HALF * RP;
    const size_t pstep = (size_t)64 * RP;
    const size_t tstep = 2 * hstep;
    const unsigned ldsw = (unsigned)wid * 1024u;
    const int aoff = lds_byte(wr * 64 + fr, fq * 8), boff = lds_byte(wc * 32 + fr, fq * 8);
    const int aoff8a = lds_byte(wr * 64 + fr, fq * 16) + (fq & 1) * 16, boff8a = lds_byte(wc * 32 + fr, fq * 16) + (fq & 1) * 16, aoff8b = aoff8a ^ 16, boff8b = boff8a ^ 16;
    LAS int* lidx = (LAS int*)(lds + LDS_GIDX);
    Unit cur, nxt; int ui = 0;
    if (!S.next(0, cur)) return;
    if (GATHER) {
        Unit u;
        for (int i = 0; i < 8 && S.next(i, u); ++i) if (tid < 256) lidx[i * 256 + tid] = rowidx[u.pm * 256 + tid];
        LDS_WAIT(); __syncthreads();
    }
#define PG8_ROWOFF(uidx, unit, h, i) ((unsigned)((GATHER ? lidx[(uidx) * 256 + (h) * 128 + rp_[i]] : ((unit).pm * 256 + (h) * 128 + rp_[i])) * RP + cp_[i] * 2))
#define PG8_RC_DECL() int rp_[2], cp_[2]; { int t_ = tid; asm volatile("" : "+v"(t_)); _Pragma("unroll") for (int i_ = 0; i_ < 2; ++i_) stage_rc(t_ * 16 + i_ * 8192, rp_[i_], cp_[i_]); }
#define PG8_SA(b, h) (((b) * 2 + (h)) * HTB)
#define PG8_SB(b, h) ((4 + (b) * 2 + (h)) * HTB)
#define PG8_STAGE(bufoff, gbase, voff) do { _Pragma("unroll") for (int _i = 0; _i < 2; ++_i) \
        __builtin_amdgcn_global_load_lds((const unsigned*)((const char*)(gbase) + (size_t)_i * pstep + (voff)[0]), (LAS unsigned*)(lds + (bufoff) + ldsw + _i * 8192), 16, 0, 0); } while (0)
#define PG8_STAGE_A(bufoff, gbase, voff) do { if constexpr (GATHER) { _Pragma("unroll") for (int _i = 0; _i < 2; ++_i) \
        __builtin_amdgcn_global_load_lds((const unsigned*)((const char*)(gbase) + (voff)[_i]), (LAS unsigned*)(lds + (bufoff) + ldsw + _i * 8192), 16, 0, 0); } else PG8_STAGE(bufoff, gbase, voff); } while (0)
#define PG8_LDA(dst, b, h) do { if constexpr (F8) { _Pragma("unroll") for (int m = 0; m < 4; ++m) { dst[m][0] = *(const LAS bf16x8*)(lds + PG8_SA(b, h) + aoff8a + m * 2048); dst[m][1] = *(const LAS bf16x8*)(lds + PG8_SA(b, h) + aoff8b + m * 2048); } } \
        else { _Pragma("unroll") for (int m = 0; m < 4; ++m) _Pragma("unroll") for (int k = 0; k < 2; ++k) dst[m][k] = *(const LAS bf16x8*)(lds + PG8_SA(b, h) + aoff + m * 2048 + k * 1024); } } while (0)
#define PG8_LDB(dst, b, h) do { if constexpr (F8) { _Pragma("unroll") for (int n = 0; n < 2; ++n) { dst[n][0] = *(const LAS bf16x8*)(lds + PG8_SB(b, h) + boff8a + n * 2048); dst[n][1] = *(const LAS bf16x8*)(lds + PG8_SB(b, h) + boff8b + n * 2048); } } \
        else { _Pragma("unroll") for (int n = 0; n < 2; ++n) _Pragma("unroll") for (int k = 0; k < 2; ++k) dst[n][k] = *(const LAS bf16x8*)(lds + PG8_SB(b, h) + boff + n * 2048 + k * 1024); } } while (0)
#define PG8_F8FRAG(X) __builtin_bit_cast(v8i_t, (frag2_t){X[0], X[1]})
#define PG8_MMA(ai, bj, At, Bt_) do { __builtin_amdgcn_s_setprio(1); if constexpr (F8) { _Pragma("unroll") for (int m = 0; m < 4; ++m) _Pragma("unroll") for (int n = 0; n < 2; ++n) \
            acc[ai][bj][m][n] = __builtin_amdgcn_mfma_scale_f32_16x16x128_f8f6f4(PG8_F8FRAG(Bt_[n]), PG8_F8FRAG(At[m]), acc[ai][bj][m][n], 0, 0, 0, 0, 0, 0); } \
        else { _Pragma("unroll") for (int m = 0; m < 4; ++m) _Pragma("unroll") for (int n = 0; n < 2; ++n) _Pragma("unroll") for (int k = 0; k < 2; ++k) \
        acc[ai][bj][m][n] = __builtin_amdgcn_mfma_f32_16x16x32_bf16(Bt_[n][k], At[m][k], acc[ai][bj][m][n], 0, 0, 0); } __builtin_amdgcn_s_setprio(0); } while (0)
#define PG8_WAIT_V(n) asm volatile("s_waitcnt vmcnt(" #n ")" ::: "memory")
#define PG8_WAIT_L(n) asm volatile("s_waitcnt lgkmcnt(" #n ")" ::: "memory")
#define PG8_BAR __builtin_amdgcn_s_barrier()
#define PG8_SCHED __builtin_amdgcn_sched_barrier(0)
    f32x4 acc[2][2][4][2];
#pragma unroll
    for (int a = 0; a < 2; ++a)
#pragma unroll
        for (int b = 0; b < 2; ++b)
#pragma unroll
            for (int m = 0; m < 4; ++m)
#pragma unroll
                for (int n = 0; n < 2; ++n) acc[a][b][m][n] = (f32x4){0.f, 0.f, 0.f, 0.f};
    bf16x8 At[4][2], B0[2][2], B1[2][2];
    unsigned offA0[2], offA1[2];
    { PG8_RC_DECL();
#pragma unroll
      for (int i = 0; i < (GATHER ? 2 : 1); ++i) { offA0[i] = PG8_ROWOFF(0, cur, 0, i); offA1[i] = PG8_ROWOFF(0, cur, 1, i); } }
    const char* Ab = (const char*)A;
    const char* cB = (const char*)Bt + (size_t)cur.pn * tstep;
    PG8_STAGE(PG8_SB(0, 0), cB, voffB); PG8_STAGE(PG8_SB(0, 1), cB + hstep, voffB); PG8_STAGE_A(PG8_SA(0, 0), Ab, offA0); PG8_STAGE_A(PG8_SA(0, 1), Ab, offA1);
    if (wr == 1) PG8_BAR;
    PG8_WAIT_V(2); PG8_BAR;
    PG8_STAGE(PG8_SB(1, 0), cB + kstep, voffB); PG8_STAGE_A(PG8_SA(1, 0), Ab + kstep, offA0); PG8_STAGE(PG8_SB(1, 1), cB + hstep + kstep, voffB);
    PG8_WAIT_V(6); PG8_BAR;
    float egv[2][4];
    int nst = 0;
    for (;;) {
        const bool has_next = S.next(ui + 1, nxt);
        const char* nB = has_next ? (const char*)Bt + (size_t)nxt.pn * tstep : cB;
#pragma unroll 1
        for (int t = 0; t < nt; t += 2) {
            const bool last = (t == nt - 2);
            const char* a1 = Ab + (size_t)(t + 1) * kstep;
            const char* a2 = last ? Ab : Ab + (size_t)(t + 2) * kstep; const char* b2 = last ? nB : cB + (size_t)(t + 2) * kstep;
            const char* a3 = a2 + kstep; const char* b3 = b2 + kstep;
            if constexpr (epi_preload<Epi>::value) { if (last) E.preload(cur, wr, fr, egv); }
            PG8_LDB(B0, 0, 0); PG8_LDB(B1, 0, 1); PG8_SCHED; PG8_LDA(At, 0, 0); PG8_STAGE_A(PG8_SA(1, 1), a1, offA1);
            if (last && has_next) {
                PG8_RC_DECL();
#pragma unroll
                for (int i = 0; i < (GATHER ? 2 : 1); ++i) { offA0[i] = PG8_ROWOFF(ui + 1, nxt, 0, i); offA1[i] = PG8_ROWOFF(ui + 1, nxt, 1, i); }
            }
            if (epi_preload<Epi>::value && last) PG8_WAIT_V(16); else if (t == 0 && nst == 16) PG8_WAIT_V(24); else if (t == 0 && nst == 8) PG8_WAIT_V(16); else PG8_WAIT_V(8);
            PG8_WAIT_L(0); PG8_BAR; PG8_MMA(0, 0, At, B0); PG8_MMA(0, 1, At, B1); PG8_BAR; PG8_SCHED;
            PG8_LDA(At, 0, 1); PG8_STAGE(PG8_SB(0, 0), b2, voffB); PG8_STAGE(PG8_SB(0, 1), b2 + hstep, voffB); PG8_STAGE_A(PG8_SA(0, 0), a2, offA0);
            if (epi_preload<Epi>::value && last) PG8_WAIT_V(16); else if (t == 0 && nst == 16) PG8_WAIT_V(24); else if (t == 0 && nst == 8) PG8_WAIT_V(16); else PG8_WAIT_V(8);
            PG8_WAIT_L(0); PG8_BAR; PG8_MMA(1, 0, At, B0); PG8_MMA(1, 1, At, B1); PG8_BAR; PG8_SCHED;
            PG8_LDB(B0, 1, 0); PG8_LDB(B1, 1, 1); PG8_SCHED; PG8_LDA(At, 1, 0); PG8_STAGE_A(PG8_SA(0, 1), a2, offA1);
            PG8_WAIT_V(8); PG8_WAIT_L(0); PG8_BAR; PG8_MMA(0, 0, At, B0); PG8_MMA(0, 1, At, B1); PG8_BAR; PG8_SCHED;
            PG8_LDA(At, 1, 1); PG8_STAGE(PG8_SB(1, 0), b3, voffB); PG8_STAGE(PG8_SB(1, 1), b3 + hstep, voffB); PG8_STAGE_A(PG8_SA(1, 0), a3, offA0);
            PG8_WAIT_V(8); PG8_WAIT_L(0); PG8_BAR; PG8_MMA(1, 0, At, B0); PG8_MMA(1, 1, At, B1); PG8_BAR; PG8_SCHED;
        }
        if (wr == 0) PG8_BAR;
        if constexpr (epi_preload<Epi>::value) E(acc, cur, wr, wc, fr, fq, egv); else E(acc, cur, wr, wc, fr, fq);
        nst = E.nstores(cur, wc);
        if (S.slot(ui)) nst = 0;
        if (!has_next) break;
#pragma unroll
        for (int a = 0; a < 2; ++a)
#pragma unroll
            for (int b = 0; b < 2; ++b)
#pragma unroll
                for (int m = 0; m < 4; ++m)
#pragma unroll
                    for (int n = 0; n < 2; ++n) acc[a][b][m][n] = (f32x4){0.f, 0.f, 0.f, 0.f};
        cur = nxt; cB = nB; ++ui;
        if (wr == 1) PG8_BAR;
    }
    PG8_WAIT_V(0);
    PG8_BAR;
#undef PG8_ROWOFF
#undef PG8_RC_DECL
#undef PG8_SA
#undef PG8_SB
#undef PG8_STAGE
#undef PG8_STAGE_A
#undef PG8_LDA
#undef PG8_LDB
#undef PG8_MMA
#undef PG8_F8FRAG
#undef PG8_WAIT_V
#undef PG8_WAIT_L
#undef PG8_BAR
#undef PG8_SCHED
}

template <class Epi, class Sched>
__device__ __forceinline__ void gemm_phase_mix(LAS unsigned char* lds, const unsigned char* A8, const unsigned char* B8, const int RP8, const int nt8,
                                               const unsigned char* A16, const unsigned char* B16, const int RP16, const int nt16, const float scale8, const Sched& S, const Epi& E) {
    int tid_ = threadIdx.x; asm volatile("" : "+v"(tid_));
    const int tid = tid_, wid = __builtin_amdgcn_readfirstlane(tid >> 6), lane = tid & 63, wr = wid >> 2, wc = wid & 3, fr = lane & 15, fq = lane >> 4;
    unsigned vB8[1], vB16[1];
    { int R, C; stage_rc(tid * 16, R, C); const int Rb = Epi::PERM ? ((R & ~31) + perm32(R & 31)) : R; vB8[0] = (unsigned)(Rb * RP8 + C * 2); vB16[0] = (unsigned)(Rb * RP16 + C * 2); }
    const size_t kstep = (size_t)(BK * 2);
    const size_t hstep8 = (size_t)HALF * RP8, hstep16 = (size_t)HALF * RP16, pstep8 = (size_t)64 * RP8, pstep16 = (size_t)64 * RP16, tstep8 = 2 * hstep8, tstep16 = 2 * hstep16;
    const unsigned ldsw = (unsigned)wid * 1024u;
    Unit cur, nxt; int ui = 0;
    if (!S.next(0, cur)) return;
#define MX_SA(b, h) (((b) * 2 + (h)) * HTB)
#define MX_SB(b, h) ((4 + (b) * 2 + (h)) * HTB)
#define MX_ROWS(unit) do { int t_ = tid; asm volatile("" : "+v"(t_)); int rp_, cp_; stage_rc(t_ * 16, rp_, cp_); \
        oA0_8[0] = (unsigned)(((unit).pm * 256 + rp_) * RP8 + cp_ * 2); oA0_16[0] = (unsigned)(((unit).pm * 256 + rp_) * RP16 + cp_ * 2); } while (0)
#define MX_STAGE8(bufoff, gbase, voff) do { _Pragma("unroll") for (int _i = 0; _i < 2; ++_i) \
        __builtin_amdgcn_global_load_lds((const unsigned*)((const char*)(gbase) + (size_t)_i * pstep8 + (voff)[0]), (LAS unsigned*)(lds + (bufoff) + ldsw + _i * 8192), 16, 0, 0); } while (0)
#define MX_STAGE16(bufoff, gbase, voff) do { _Pragma("unroll") for (int _i = 0; _i < 2; ++_i) \
        __builtin_amdgcn_global_load_lds((const unsigned*)((const char*)(gbase) + (size_t)_i * pstep16 + (voff)[0]), (LAS unsigned*)(lds + (bufoff) + ldsw + _i * 8192), 16, 0, 0); } while (0)
#define MX_LDA8(dst, b, h) do { _Pragma("unroll") for (int m = 0; m < 4; ++m) { dst[m][0] = *(const LAS bf16x8*)(lds + MX_SA(b, h) + aoff8a + m * 2048); dst[m][1] = *(const LAS bf16x8*)(lds + MX_SA(b, h) + aoff8b + m * 2048); } } while (0)
#define MX_LDB8(dst, b, h) do { _Pragma("unroll") for (int n = 0; n < 2; ++n) { dst[n][0] = *(const LAS bf16x8*)(lds + MX_SB(b, h) + boff8a + n * 2048); dst[n][1] = *(const LAS bf16x8*)(lds + MX_SB(b, h) + boff8b + n * 2048); } } while (0)
#define MX_LDA16(dst, b, h) do { _Pragma("unroll") for (int m = 0; m < 4; ++m) _Pragma("unroll") for (int k = 0; k < 2; ++k) dst[m][k] = *(const LAS bf16x8*)(lds + MX_SA(b, h) + aoff + m * 2048 + k * 1024); } while (0)
#define MX_LDB16(dst, b, h) do { _Pragma("unroll") for (int n = 0; n < 2; ++n) _Pragma("unroll") for (int k = 0; k < 2; ++k) dst[n][k] = *(const LAS bf16x8*)(lds + MX_SB(b, h) + boff + n * 2048 + k * 1024); } while (0)
#define MX_F8FRAG(X) __builtin_bit_cast(v8i_t, (frag2_t){X[0], X[1]})
#define MX_MMA8(ai, bj, At, Bt_) do { __builtin_amdgcn_s_setprio(1); _Pragma("unroll") for (int m = 0; m < 4; ++m) _Pragma("unroll") for (int n = 0; n < 2; ++n) \
            acc[ai][bj][m][n] = __builtin_amdgcn_mfma_scale_f32_16x16x128_f8f6f4(MX_F8FRAG(Bt_[n]), MX_F8FRAG(At[m]), acc[ai][bj][m][n], 0, 0, 0, 0, 0, 0); __builtin_amdgcn_s_setprio(0); } while (0)
#define MX_MMA16(ai, bj, At, Bt_) do { __builtin_amdgcn_s_setprio(1); _Pragma("unroll") for (int m = 0; m < 4; ++m) _Pragma("unroll") for (int n = 0; n < 2; ++n) _Pragma("unroll") for (int k = 0; k < 2; ++k) \
        acc[ai][bj][m][n] = __builtin_amdgcn_mfma_f32_16x16x32_bf16(Bt_[n][k], At[m][k], acc[ai][bj][m][n], 0, 0, 0); __builtin_amdgcn_s_setprio(0); } while (0)
#define MX_W8() asm volatile("s_waitcnt vmcnt(8)" ::: "memory")
#define MX_WL() asm volatile("s_waitcnt lgkmcnt(0)" ::: "memory")
#define MX_BAR __builtin_amdgcn_s_barrier()
#define MX_SCHED __builtin_amdgcn_sched_barrier(0)
    f32x4 acc[2][2][4][2];
#pragma unroll
    for (int a = 0; a < 2; ++a)
#pragma unroll
        for (int b = 0; b < 2; ++b)
#pragma unroll
            for (int m = 0; m < 4; ++m)
#pragma unroll
                for (int n = 0; n < 2; ++n) acc[a][b][m][n] = (f32x4){0.f, 0.f, 0.f, 0.f};
    bf16x8 At[4][2], B0[2][2], B1[2][2];
    unsigned oA0_8[1], oA0_16[1];
    MX_ROWS(cur);
    const char* cB8 = (const char*)B8 + (size_t)cur.pn * tstep8; const char* cB16 = (const char*)B16 + (size_t)cur.pn * tstep16;
    const char* Ab8 = (const char*)A8; const char* Ab16 = (const char*)A16;
    MX_STAGE8(MX_SB(0, 0), cB8, vB8); MX_STAGE8(MX_SB(0, 1), cB8 + hstep8, vB8); MX_STAGE8(MX_SA(0, 0), Ab8, oA0_8); MX_STAGE8(MX_SA(0, 1), (Ab8) + hstep8, oA0_8);
    if (wr == 1) MX_BAR;
    asm volatile("s_waitcnt vmcnt(2)" ::: "memory"); MX_BAR;
    MX_STAGE8(MX_SB(1, 0), cB8 + kstep, vB8); MX_STAGE8(MX_SA(1, 0), Ab8 + kstep, oA0_8); MX_STAGE8(MX_SB(1, 1), cB8 + hstep8 + kstep, vB8);
    asm volatile("s_waitcnt vmcnt(6)" ::: "memory"); MX_BAR;
    for (;;) {
        const bool has_next = S.next(ui + 1, nxt);
        const char* nB8 = has_next ? (const char*)B8 + (size_t)nxt.pn * tstep8 : cB8;
        int l8_ = lane; asm volatile("" : "+v"(l8_)); const int fr8 = l8_ & 15, fq8 = l8_ >> 4;
        const int aoff8a = lds_byte(wr * 64 + fr8, fq8 * 16) + (fq8 & 1) * 16, boff8a = lds_byte(wc * 32 + fr8, fq8 * 16) + (fq8 & 1) * 16, aoff8b = aoff8a ^ 16, boff8b = boff8a ^ 16;
#pragma unroll 1
        for (int t = 0; t < nt8; t += 2) {
            const bool last = (t == nt8 - 2);
            const char* a1 = Ab8 + (size_t)(t + 1) * kstep;
            const char* a2 = Ab8 + (size_t)(t + 2) * kstep; const char* b2 = cB8 + (size_t)(t + 2) * kstep;
            MX_LDB8(B0, 0, 0); MX_LDB8(B1, 0, 1); MX_SCHED; MX_LDA8(At, 0, 0); MX_STAGE8(MX_SA(1, 1), (a1) + hstep8, oA0_8);
            MX_W8(); MX_WL(); MX_BAR; MX_MMA8(0, 0, At, B0); MX_MMA8(0, 1, At, B1); MX_BAR; MX_SCHED;
            MX_LDA8(At, 0, 1);
            if (!last) { MX_STAGE8(MX_SB(0, 0), b2, vB8); MX_STAGE8(MX_SB(0, 1), b2 + hstep8, vB8); MX_STAGE8(MX_SA(0, 0), a2, oA0_8); }
            else { MX_STAGE16(MX_SB(0, 0), cB16, vB16); MX_STAGE16(MX_SB(0, 1), cB16 + hstep16, vB16); MX_STAGE16(MX_SA(0, 0), Ab16, oA0_16); }
            MX_W8(); MX_WL(); MX_BAR; MX_MMA8(1, 0, At, B0); MX_MMA8(1, 1, At, B1); MX_BAR; MX_SCHED;
            MX_LDB8(B0, 1, 0); MX_LDB8(B1, 1, 1); MX_SCHED; MX_LDA8(At, 1, 0);
            if (!last) MX_STAGE8(MX_SA(0, 1), (a2) + hstep8, oA0_8); else MX_STAGE16(MX_SA(0, 1), (Ab16) + hstep16, oA0_16);
            MX_W8(); MX_WL(); MX_BAR; MX_MMA8(0, 0, At, B0); MX_MMA8(0, 1, At, B1); MX_BAR; MX_SCHED;
            MX_LDA8(At, 1, 1);
            if (!last) { MX_STAGE8(MX_SB(1, 0), b2 + kstep, vB8); MX_STAGE8(MX_SB(1, 1), b2 + kstep + hstep8, vB8); MX_STAGE8(MX_SA(1, 0), a2 + kstep, oA0_8); }
            else { MX_STAGE16(MX_SB(1, 0), cB16 + kstep, vB16); MX_STAGE16(MX_SB(1, 1), cB16 + kstep + hstep16, vB16); MX_STAGE16(MX_SA(1, 0), Ab16 + kstep, oA0_16); }
            MX_W8(); MX_WL(); MX_BAR; MX_MMA8(1, 0, At, B0); MX_MMA8(1, 1, At, B1); MX_BAR; MX_SCHED;
        }
#pragma unroll
        for (int a = 0; a < 2; ++a)
#pragma unroll
            for (int b = 0; b < 2; ++b)
#pragma unroll
                for (int m = 0; m < 4; ++m)
#pragma unroll
                    for (int n = 0; n < 2; ++n) acc[a][b][m][n] = acc[a][b][m][n] * scale8;
        int l16_ = lane; asm volatile("" : "+v"(l16_)); const int fr16 = l16_ & 15, fq16 = l16_ >> 4;
        const int aoff = lds_byte(wr * 64 + fr16, fq16 * 8), boff = lds_byte(wc * 32 + fr16, fq16 * 8);
#pragma unroll 1
        for (int t = 0; t < nt16; t += 2) {
            const bool last = (t == nt16 - 2);
            const char* a1 = Ab16 + (size_t)(t + 1) * kstep;
            const char* a2 = Ab16 + (size_t)(t + 2) * kstep; const char* b2 = cB16 + (size_t)(t + 2) * kstep;
            MX_LDB16(B0, 0, 0); MX_LDB16(B1, 0, 1); MX_SCHED; MX_LDA16(At, 0, 0); MX_STAGE16(MX_SA(1, 1), (a1) + hstep16, oA0_16);
            if (last && has_next) MX_ROWS(nxt);
            MX_W8(); MX_WL(); MX_BAR; MX_MMA16(0, 0, At, B0); MX_MMA16(0, 1, At, B1); MX_BAR; MX_SCHED;
            MX_LDA16(At, 0, 1);
            if (!last) { MX_STAGE16(MX_SB(0, 0), b2, vB16); MX_STAGE16(MX_SB(0, 1), b2 + hstep16, vB16); MX_STAGE16(MX_SA(0, 0), a2, oA0_16); }
            else { MX_STAGE8(MX_SB(0, 0), nB8, vB8); MX_STAGE8(MX_SB(0, 1), nB8 + hstep8, vB8); MX_STAGE8(MX_SA(0, 0), Ab8, oA0_8); }
            MX_W8(); MX_WL(); MX_BAR; MX_MMA16(1, 0, At, B0); MX_MMA16(1, 1, At, B1); MX_BAR; MX_SCHED;
            MX_LDB16(B0, 1, 0); MX_LDB16(B1, 1, 1); MX_SCHED; MX_LDA16(At, 1, 0);
            if (!last) MX_STAGE16(MX_SA(0, 1), (a2) + hstep16, oA0_16); else MX_STAGE8(MX_SA(0, 1), (Ab8) + hstep8, oA0_8);
            MX_W8(); MX_WL(); MX_BAR; MX_MMA16(0, 0, At, B0); MX_MMA16(0, 1, At, B1); MX_BAR; MX_SCHED;
            MX_LDA16(At, 1, 1);
            if (!last) { MX_STAGE16(MX_SB(1, 0), b2 + kstep, vB16); MX_STAGE16(MX_SB(1, 1), b2 + kstep + hstep16, vB16); MX_STAGE16(MX_SA(1, 0), a2 + kstep, oA0_16); }
            else { MX_STAGE8(MX_SB(1, 0), nB8 + kstep, vB8); MX_STAGE8(MX_SB(1, 1), nB8 + kstep + hstep8, vB8); MX_STAGE8(MX_SA(1, 0), Ab8 + kstep, oA0_8); }
            MX_W8(); MX_WL(); MX_BAR; MX_MMA16(1, 0, At, B0); MX_MMA16(1, 1, At, B1); MX_BAR; MX_SCHED;
        }
        if (wr == 0) MX_BAR;
        E(acc, cur, wr, wc, fr, fq);
        if (!has_next) break;
#pragma unroll
        for (int a = 0; a < 2; ++a)
#pragma unroll
            for (int b = 0; b < 2; ++b)
#pragma unroll
                for (int m = 0; m < 4; ++m)
#pragma unroll
                    for (int n = 0; n < 2; ++n) acc[a][b][m][n] = (f32x4){0.f, 0.f, 0.f, 0.f};
        cur = nxt; cB8 = nB8; cB16 = (const char*)B16 + (size_t)cur.pn * tstep16; ++ui;
        if (wr == 1) MX_BAR;
    }
    asm volatile("s_waitcnt vmcnt(0)" ::: "memory");
    MX_BAR;
#undef MX_SA
#undef MX_SB
#undef MX_ROWS
#undef MX_STAGE8
#undef MX_STAGE16
#undef MX_LDA8
#undef MX_LDB8
#undef MX_LDA16
#undef MX_LDB16
#undef MX_F8FRAG
#undef MX_MMA8
#undef MX_MMA16
#undef MX_W8
#undef MX_WL
#undef MX_BAR
#undef MX_SCHED
}

#define EPI_LOOP_AM _Pragma("unroll") for (int ai = 0; ai < 2; ++ai) _Pragma("unroll") for (int m = 0; m < 4; ++m)
typedef const f32x4 (&AccRef)[2][2][4][2];

struct EpiProj {
    static constexpr bool PERM = true;
    bf16_t* proj; float* gates;
    __device__ __forceinline__ int nstores(const Unit& u, int wc) const { return (u.pn < 18 || wc == 0) ? 16 : 0; }
    __device__ __forceinline__ void operator()(AccRef acc, const Unit& u, int wr, int wc, int fr, int fq) const {
        const int row0 = u.pm * BM + wr * 64 + fr;
        if (u.pn < 18) {
            const int col0 = u.pn * BM + wc * 32 + 8 * fq;
            EPI_LOOP_AM { bf16_t* rowp = proj + (size_t)(row0 + ai * HALF + m * 16) * PJ_LD + col0;
#pragma unroll
                for (int bj = 0; bj < 2; ++bj) { const f32x4 v0 = acc[ai][bj][m][0], v1 = acc[ai][bj][m][1];
                    u32x4 w; w.x = cvt_pk_bf16(v0[0], v0[1]); w.y = cvt_pk_bf16(v0[2], v0[3]); w.z = cvt_pk_bf16(v1[0], v1[1]); w.w = cvt_pk_bf16(v1[2], v1[3]);
                    __builtin_nontemporal_store(w, (u32x4*)(rowp + bj * HALF)); } }
        } else if (wc == 0) {
            EPI_LOOP_AM { float* rowp = gates + (size_t)(row0 + ai * HALF + m * 16) * 32 + 8 * fq;
                *(f32x4*)(rowp) = acc[ai][0][m][0]; *(f32x4*)(rowp + 4) = acc[ai][0][m][1]; }
        }
    }
};
struct EpiProj8 {
    static constexpr bool PERM = true;
    bf16_t* proj;
    __device__ __forceinline__ int nstores(const Unit&, int) const { return 16; }
    __device__ __forceinline__ void operator()(AccRef acc, const Unit& u, int wr, int wc, int fr, int fq) const {
        const int pno = u.pn < 6 ? u.pn : u.pn + 8;
        const int row0 = u.pm * BM + wr * 64 + fr, col0 = pno * BM + wc * 32 + 8 * fq;
        EPI_LOOP_AM { bf16_t* rowp = proj + (size_t)(row0 + ai * HALF + m * 16) * PJ_LD + col0;
#pragma unroll
            for (int bj = 0; bj < 2; ++bj) { const f32x4 v0 = acc[ai][bj][m][0] * (1.0f / 64.0f), v1 = acc[ai][bj][m][1] * (1.0f / 64.0f);
                u32x4 w; w.x = cvt_pk_bf16(v0[0], v0[1]); w.y = cvt_pk_bf16(v0[2], v0[3]); w.z = cvt_pk_bf16(v1[0], v1[1]); w.w = cvt_pk_bf16(v1[2], v1[3]);
                __builtin_nontemporal_store(w, (u32x4*)(rowp + bj * HALF)); } }
    }
};
struct EpiOut {
    static constexpr bool PERM = true;
    const bf16_t* xb; bf16_t* y;
    __device__ __forceinline__ int nstores(const Unit&, int) const { return 0; }
    __device__ __forceinline__ void operator()(AccRef acc, const Unit& u, int wr, int wc, int fr, int fq) const {
        const int row0 = u.pm * BM + wr * 64 + fr, col0 = u.pn * BM + wc * 32 + 8 * fq;
#pragma unroll
        for (int ai = 0; ai < 2; ++ai) {
            u32x4 xv[4][2];
#pragma unroll
            for (int m = 0; m < 4; ++m)
#pragma unroll
                for (int bj = 0; bj < 2; ++bj) xv[m][bj] = __builtin_nontemporal_load((const u32x4*)(xb + (size_t)(row0 + ai * HALF + m * 16) * DM + col0 + bj * HALF));
#pragma unroll
            for (int m = 0; m < 4; ++m) { const size_t off = (size_t)(row0 + ai * HALF + m * 16) * DM + col0;
#pragma unroll
                for (int bj = 0; bj < 2; ++bj) { const u32x4 xw = xv[m][bj];
                    const f32x4 x0 = {bf_lo(xw.x), bf_hi(xw.x), bf_lo(xw.y), bf_hi(xw.y)}, x1 = {bf_lo(xw.z), bf_hi(xw.z), bf_lo(xw.w), bf_hi(xw.w)};
                    const f32x4 v0 = x0 * ALPHA + acc[ai][bj][m][0], v1 = x1 * ALPHA + acc[ai][bj][m][1];
                    u32x4 w; w.x = cvt_pk_bf16(v0[0], v0[1]); w.y = cvt_pk_bf16(v0[2], v0[3]); w.z = cvt_pk_bf16(v1[0], v1[1]); w.w = cvt_pk_bf16(v1[2], v1[3]);
                    *(u32x4*)(y + off + bj * HALF) = w; } }
        }
    }
};
struct EpiGU {
    static constexpr bool PERM = true;
    unsigned char* hid;
    __device__ __forceinline__ int nstores(const Unit&, int) const { return 8; }
    __device__ __forceinline__ void operator()(AccRef acc, const Unit& u, int wr, int wc, int fr, int fq) const {
        const int row0 = u.pm * BM + wr * 64 + fr, col0 = (u.pn & 7) * 128 + wc * 32 + 8 * fq;
        EPI_LOOP_AM { unsigned char* rowp = hid + (size_t)(row0 + ai * HALF + m * 16) * FF + col0;
            f32x4 h[2];
#pragma unroll
            for (int n = 0; n < 2; ++n) { const f32x4 g = acc[ai][0][m][n], u = acc[ai][1][m][n]; const f32x4 t = g * (-1.4426950408889634f / 64.0f);
                f32x4 e; e[0] = __builtin_amdgcn_exp2f(t[0]); e[1] = __builtin_amdgcn_exp2f(t[1]); e[2] = __builtin_amdgcn_exp2f(t[2]); e[3] = __builtin_amdgcn_exp2f(t[3]);
                const f32x4 d = e + 1.0f; f32x4 sg; sg[0] = __builtin_amdgcn_rcpf(d[0]); sg[1] = __builtin_amdgcn_rcpf(d[1]); sg[2] = __builtin_amdgcn_rcpf(d[2]); sg[3] = __builtin_amdgcn_rcpf(d[3]);
                h[n] = (g * u) * (sg * (1.0f / 512.0f)); }
            u32x2 w; w.x = pk4_fp8(h[0][0], h[0][1], h[0][2], h[0][3]); w.y = pk4_fp8(h[1][0], h[1][1], h[1][2], h[1][3]);
            *(u32x2*)rowp = w; }
    }
};
struct EpiDown {
    static constexpr bool PERM = true;
    static constexpr bool PRELOAD = true;
    unsigned char* y; const float* gatev;
    __device__ __forceinline__ void preload(const Unit& u, int wr, int fr, float (&gv)[2][4]) const { const int row0 = u.pm * BM + wr * 64 + fr; EPI_LOOP_AM gv[ai][m] = gatev[row0 + ai * HALF + m * 16]; }
    __device__ __forceinline__ int nstores(const Unit&, int) const { return 16; }
    __device__ __forceinline__ void operator()(AccRef acc, const Unit& u, int wr, int wc, int fr, int fq, const float (&gv)[2][4]) const {
        const int row0 = u.pm * BM + wr * 64 + fr, col0 = (u.pn & 7) * BM + wc * 32 + 8 * fq;
        EPI_LOOP_AM { const int row = row0 + ai * HALF + m * 16; const float g = gv[ai][m]; unsigned char* rowp = y + (size_t)row * DM + col0;
#pragma unroll
            for (int bj = 0; bj < 2; ++bj) { const f32x4 v0 = acc[ai][bj][m][0] * g, v1 = acc[ai][bj][m][1] * g;
                u32x2 w; w.x = pk4_fp8(v0[0], v0[1], v0[2], v0[3]); w.y = pk4_fp8(v1[0], v1[1], v1[2], v1[3]);
                *(u32x2*)(rowp + bj * HALF) = w; } }
    }
};
struct EpiPlain {
    static constexpr bool PERM = true;
    bf16_t* o;
    __device__ __forceinline__ int nstores(const Unit&, int) const { return 16; }
    __device__ __forceinline__ void operator()(AccRef acc, const Unit& u, int wr, int wc, int fr, int fq) const {
        const int row0 = u.pm * BM + wr * 64 + fr, col0 = u.pn * BM + wc * 32 + 8 * fq;
        EPI_LOOP_AM { bf16_t* rowp = o + (size_t)(row0 + ai * HALF + m * 16) * DM + col0;
#pragma unroll
            for (int bj = 0; bj < 2; ++bj) { const f32x4 v0 = acc[ai][bj][m][0], v1 = acc[ai][bj][m][1];
                u32x4 w; w.x = cvt_pk_bf16(v0[0], v0[1]); w.y = cvt_pk_bf16(v0[2], v0[3]); w.z = cvt_pk_bf16(v1[0], v1[1]); w.w = cvt_pk_bf16(v1[2], v1[3]);
                *(u32x4*)(rowp + bj * HALF) = w; } }
    }
};
struct EpiPlGate {
    static constexpr bool PERM = true;
    unsigned char* tg8; const float* bias;
    __device__ __forceinline__ int nstores(const Unit&, int) const { return 16; }
    __device__ __forceinline__ void operator()(AccRef acc, const Unit& u, int wr, int wc, int fr, int fq) const {
        const int row0 = u.pm * BM + wr * 64 + fr, col0 = u.pn * BM + wc * 32 + 8 * fq;
        f32x4 bv[2][2];
#pragma unroll
        for (int bj = 0; bj < 2; ++bj)
#pragma unroll
            for (int n = 0; n < 2; ++n) bv[bj][n] = *(const f32x4*)(bias + col0 + bj * HALF + 4 * n);
        f32x4 nb[2][2];
#pragma unroll
        for (int bj = 0; bj < 2; ++bj)
#pragma unroll
            for (int n = 0; n < 2; ++n) nb[bj][n] = bv[bj][n] * -1.4426950408889634f;
        EPI_LOOP_AM { unsigned char* rowp = tg8 + (size_t)(row0 + ai * HALF + m * 16) * DM + col0;
#pragma unroll
            for (int bj = 0; bj < 2; ++bj) {
                const f32x4 t0 = acc[ai][bj][m][0] * (-1.4426950408889634f * 8.0f / 64.0f) + nb[bj][0] * 8.0f, t1 = acc[ai][bj][m][1] * (-1.4426950408889634f * 8.0f / 64.0f) + nb[bj][1] * 8.0f;
                u32x2 w; w.x = pk4_fp8(t0[0], t0[1], t0[2], t0[3]); w.y = pk4_fp8(t1[0], t1[1], t1[2], t1[3]);
                *(u32x2*)(rowp + bj * HALF) = w; } }
    }
};
}

namespace att {
constexpr int D = 128, NW = 8, QBLK = 32, KVBLK = 64;
constexpr float SCALE = 0.088388347648318440f;
constexpr float THR = 8.f;
constexpr int LDQ = PJ_LD, LDK = PJ_LD, LDO = DM, LDO8 = 1024;
constexpr size_t SHM_V = KVBLK * D * 2, SHM_K = KVBLK * D * 2;
#define KSWZ(row, colB) ((row) * 256 + ((colB) ^ (((row) & 7) << 4)))
#define SBAR() __builtin_amdgcn_sched_barrier(0)
__device__ __forceinline__ int crow(int r, int hi) { return (r & 3) + 8 * (r >> 2) + 4 * hi; }
__device__ __forceinline__ unsigned cvtpk(float lo, float hi) { unsigned r; asm volatile("v_cvt_pk_bf16_f32 %0, %1, %2" : "=v"(r) : "v"(lo), "v"(hi)); return r; }
__device__ __forceinline__ bf16x8 ld8(const bf16_t* p) { return *reinterpret_cast<const bf16x8*>(p); }

__device__ __forceinline__ void partialSM(f32x16& p0, f32x16& p1, float& m_reg, float& mn, float& alpha) {
    constexpr float C = SCALE * 1.4426950408889634f;
    float pmax = p0[0]; for (int r = 1; r < 16; ++r) pmax = fmaxf(pmax, p0[r]); for (int r = 0; r < 16; ++r) pmax = fmaxf(pmax, p1[r]);
    { auto rr = __builtin_amdgcn_permlane32_swap(__float_as_uint(pmax), __float_as_uint(pmax), false, false);
      pmax = fmaxf(__uint_as_float(rr[0]), __uint_as_float(rr[1])); }
    if (__builtin_expect(__all(pmax - m_reg <= THR / SCALE), 1)) { mn = m_reg; alpha = 1.f; }
    else { mn = fmaxf(m_reg, pmax); alpha = __builtin_amdgcn_exp2f((m_reg - mn) * C); m_reg = mn; }
    float mnC = -mn * C;
    for (int r = 0; r < 16; ++r) p0[r] = fmaf(p0[r], C, mnC); for (int r = 0; r < 16; ++r) p1[r] = fmaf(p1[r], C, mnC);
    for (int r = 0; r < 16; ++r) p0[r] = __builtin_amdgcn_exp2f(p0[r]);
}
__device__ __forceinline__ void finishSM(f32x16& p0, f32x16& p1, float alpha, float& l_reg, bf16x8& pa0, bf16x8& pa1, bf16x8& pa2, bf16x8& pa3) {
    for (int r = 0; r < 16; ++r) p1[r] = __builtin_amdgcn_exp2f(p1[r]);
    float ps = 0; for (int r = 0; r < 16; ++r) ps += p0[r]; for (int r = 0; r < 16; ++r) ps += p1[r];
    { auto rr = __builtin_amdgcn_permlane32_swap(__float_as_uint(ps), __float_as_uint(ps), false, false);
      ps = __uint_as_float(rr[0]) + __uint_as_float(rr[1]); }
    l_reg = l_reg * alpha + ps;
#define PK4(P, BASE, OUT) do { unsigned a0 = cvtpk(P[BASE + 0], P[BASE + 1]), a1 = cvtpk(P[BASE + 2], P[BASE + 3]);   \
    unsigned b0 = cvtpk(P[BASE + 4], P[BASE + 5]), b1 = cvtpk(P[BASE + 6], P[BASE + 7]);                              \
    auto r0 = __builtin_amdgcn_permlane32_swap(a0, b0, false, false); auto r1 = __builtin_amdgcn_permlane32_swap(a1, b1, false, false); \
    u32x4 w = {r0[0], r1[0], r0[1], r1[1]}; OUT = *reinterpret_cast<bf16x8*>(&w); } while (0)
    PK4(p0, 0, pa0); PK4(p0, 8, pa1); PK4(p1, 0, pa2); PK4(p1, 8, pa3);
#undef PK4
}
__device__ __forceinline__ void qkt(f32x16& p0, f32x16& p1, const bf16_t* Ks, const bf16x8* qr, int r32, int hi) {
    p0 = f32x16{}; p1 = f32x16{};
    for (int d0 = 0; d0 < 8; ++d0) { int cb = (d0 * 16 + hi * 8) * 2;
        bf16x8 b0 = *reinterpret_cast<const bf16x8*>((const char*)Ks + KSWZ(r32, cb));
        bf16x8 b1 = *reinterpret_cast<const bf16x8*>((const char*)Ks + KSWZ(32 + r32, cb));
        p0 = __builtin_amdgcn_mfma_f32_32x32x16_bf16(b0, qr[d0], p0, 0, 0, 0);
        p1 = __builtin_amdgcn_mfma_f32_32x32x16_bf16(b1, qr[d0], p1, 0, 0, 0); }
}
__device__ __forceinline__ int v_st(int k, int c) { const int kk = (k & ~0xC) | ((k & 4) << 1) | ((k & 8) >> 1); return ((kk >> 3) * 4 + (c >> 5)) * 512 + ((kk & 7) * 32 + (c & 31)) * 2; }
__device__ __forceinline__ int v_rd_base(int lane) { return ((lane & 3) << 3) | (((lane >> 2) & 3) << 6) | (((lane >> 4) & 1) << 5) | (((lane >> 5) & 1) << 8); }
constexpr int v_rd_off(int d0, int ks, int half) { return d0 * 512 + ks * 4096 + half * 2048; }
template <int OFF> __device__ __forceinline__ s16x4 tr_read(int vb) {
    s16x4 r; asm volatile("ds_read_b64_tr_b16 %0, %1 offset:%2" : "=&v"(r) : "v"(vb), "i"(OFF) : "memory"); return r;
}
template <int D0> __device__ __forceinline__ void pv_one(f32x16& od, int vb, bf16x8 pa0, bf16x8 pa1, bf16x8 pa2, bf16x8 pa3) {
    const s16x4 l0 = tr_read<v_rd_off(D0, 0, 0)>(vb), h0 = tr_read<v_rd_off(D0, 0, 1)>(vb), l1 = tr_read<v_rd_off(D0, 1, 0)>(vb), h1 = tr_read<v_rd_off(D0, 1, 1)>(vb);
    const s16x4 l2 = tr_read<v_rd_off(D0, 2, 0)>(vb), h2 = tr_read<v_rd_off(D0, 2, 1)>(vb), l3 = tr_read<v_rd_off(D0, 3, 0)>(vb), h3 = tr_read<v_rd_off(D0, 3, 1)>(vb);
    asm volatile("s_waitcnt lgkmcnt(0)" ::: "memory"); SBAR();
#define PK(L, H) (bf16x8){L[0], L[1], L[2], L[3], H[0], H[1], H[2], H[3]}
    od = __builtin_amdgcn_mfma_f32_32x32x16_bf16(pa0, PK(l0, h0), od, 0, 0, 0);
    od = __builtin_amdgcn_mfma_f32_32x32x16_bf16(pa1, PK(l1, h1), od, 0, 0, 0);
    od = __builtin_amdgcn_mfma_f32_32x32x16_bf16(pa2, PK(l2, h2), od, 0, 0, 0);
    od = __builtin_amdgcn_mfma_f32_32x32x16_bf16(pa3, PK(l3, h3), od, 0, 0, 0);
#undef PK
}
__device__ __forceinline__ void pv_d0(f32x16* o, int vb, bf16x8 pa0, bf16x8 pa1, bf16x8 pa2, bf16x8 pa3) {
    pv_one<0>(o[0], vb, pa0, pa1, pa2, pa3); pv_one<1>(o[1], vb, pa0, pa1, pa2, pa3); pv_one<2>(o[2], vb, pa0, pa1, pa2, pa3); pv_one<3>(o[3], vb, pa0, pa1, pa2, pa3);
}
__device__ __forceinline__ void attn_dense_body(const bf16_t* __restrict__ Qb, const bf16_t* __restrict__ Kh, const bf16_t* __restrict__ Vh, unsigned char* __restrict__ Ob, int seq, char* lds, const float* __restrict__ gq, const float* __restrict__ rtab, int s_base) {
    const int tid = threadIdx.x, wid = tid >> 6, lane = tid & 63, r32 = lane & 31, hi = lane >> 5;
    bf16_t* V_lds = (bf16_t*)lds; bf16_t* K_lds = (bf16_t*)(lds + 2 * SHM_V);
    float* wsl = (float*)(lds + 2 * SHM_V + 2 * SHM_K) + wid * 64; float* li_l = wsl; float* al_l = wsl + 32;
    float m_reg = -1e30f, l_reg = 0; f32x16 o[4] = {}; bf16x8 qr[8];
    const bf16_t* Qw = Qb + (long)(wid * QBLK + r32) * LDQ + hi * 8;
    const int sr = tid >> 4, sc = (tid & 15) * 8, vst0 = v_st(sr, sc), vst1 = v_st(32 + sr, sc);
    const int vb0 = (int)(uintptr_t)V_lds + v_rd_base(lane);
    struct { bf16x8 vs0, vs1, ks0, ks1; } sr_[2];
#define SLOAD(i, k0) do { sr_[i].vs0 = ld8(&Vh[(long)((k0) + sr) * LDK + sc]); sr_[i].vs1 = ld8(&Vh[(long)((k0) + 32 + sr) * LDK + sc]); \
    sr_[i].ks0 = ld8(&Kh[(long)((k0) + sr) * LDK + sc]); sr_[i].ks1 = ld8(&Kh[(long)((k0) + 32 + sr) * LDK + sc]); } while (0)
    constexpr int SE = 0, SO = 1;
    sr_[SE].ks0 = ld8(&Kh[(long)(sr) * LDK + sc]); sr_[SE].ks1 = ld8(&Kh[(long)(32 + sr) * LDK + sc]);
    {
        int h8 = hi * 8; asm volatile("" : "+v"(h8));
        bf16x8 qraw[8];
#pragma unroll
        for (int d0 = 0; d0 < 8; ++d0) qraw[d0] = ld8(Qw + d0 * 16);
        float ss = 0.f;
#pragma unroll
        for (int d0 = 0; d0 < 8; ++d0)
#pragma unroll
            for (int j = 0; j < 8; ++j) { const float v = __uint_as_float(((unsigned)(unsigned short)qraw[d0][j]) << 16); ss += v * v; }
        { auto rr = __builtin_amdgcn_permlane32_swap(__float_as_uint(ss), __float_as_uint(ss), false, false); ss = __uint_as_float(rr[0]) + __uint_as_float(rr[1]); }
        const float rn = rsqrtf(ss * (1.0f / 128.0f) + NORM_EPS);
        const int s_tok = s_base + wid * QBLK + r32;
#pragma unroll
        for (int ax = 0; ax < 2; ++ax)
#pragma unroll
            for (int fb = 0; fb < 2; ++fb) { const int pos = ax ? (s_tok & 63) : (s_tok >> 6); const float* ct = rtab + pos * 32 + fb * 16 + h8;
                const f32x4 c0 = *(const f32x4*)ct, c1 = *(const f32x4*)(ct + 4), s0 = *(const f32x4*)(ct + 2048), s1 = *(const f32x4*)(ct + 2052);
                const float cs[8] = {c0[0], c0[1], c0[2], c0[3], c1[0], c1[1], c1[2], c1[3]}, sn[8] = {s0[0], s0[1], s0[2], s0[3], s1[0], s1[1], s1[2], s1[3]};
                const int da = ax * 4 + fb, db = da + 2;
                const f32x4 ga0 = *(const f32x4*)(gq + da * 16 + h8), ga1 = *(const f32x4*)(gq + da * 16 + h8 + 4), gb0 = *(const f32x4*)(gq + db * 16 + h8), gb1 = *(const f32x4*)(gq + db * 16 + h8 + 4);
                const float gA[8] = {ga0[0], ga0[1], ga0[2], ga0[3], ga1[0], ga1[1], ga1[2], ga1[3]}, gB[8] = {gb0[0], gb0[1], gb0[2], gb0[3], gb1[0], gb1[1], gb1[2], gb1[3]};
                float xa[8], xb_[8];
#pragma unroll
                for (int j = 0; j < 8; ++j) { xa[j] = __uint_as_float(((unsigned)(unsigned short)qraw[da][j]) << 16) * rn * gA[j]; xb_[j] = __uint_as_float(((unsigned)(unsigned short)qraw[db][j]) << 16) * rn * gB[j]; }
                u32x4 wa, wb; float oa[8], ob[8];
#pragma unroll
                for (int j = 0; j < 8; ++j) { oa[j] = xa[j] * cs[j] - xb_[j] * sn[j]; ob[j] = xb_[j] * cs[j] + xa[j] * sn[j]; }
                wa.x = cvt_pk_bf16(oa[0], oa[1]); wa.y = cvt_pk_bf16(oa[2], oa[3]); wa.z = cvt_pk_bf16(oa[4], oa[5]); wa.w = cvt_pk_bf16(oa[6], oa[7]);
                wb.x = cvt_pk_bf16(ob[0], ob[1]); wb.y = cvt_pk_bf16(ob[2], ob[3]); wb.z = cvt_pk_bf16(ob[4], ob[5]); wb.w = cvt_pk_bf16(ob[6], ob[7]);
                qr[da] = __builtin_bit_cast(bf16x8, wa); qr[db] = __builtin_bit_cast(bf16x8, wb); }
    }
#define SWRITE(b, i) do { *(bf16x8*)((char*)V_lds + (b) * SHM_V + vst0) = sr_[i].vs0;          \
    *(bf16x8*)((char*)V_lds + (b) * SHM_V + vst1) = sr_[i].vs1; int kc = sc * 2;               \
    *(bf16x8*)((char*)K_lds + (b) * SHM_K + KSWZ(sr, kc)) = sr_[i].ks0;                       \
    *(bf16x8*)((char*)K_lds + (b) * SHM_K + KSWZ(32 + sr, kc)) = sr_[i].ks1; } while (0)
#define SWAIT() asm volatile("s_waitcnt vmcnt(4)" ::: "memory")
#define RESC(a) do { if (__any((a) < 1.f)) { if (hi == 0) al_l[r32] = (a); asm volatile("s_waitcnt lgkmcnt(0)" ::: "memory"); \
    for (int d = 0; d < 4; ++d) for (int r = 0; r < 16; ++r) o[d][r] *= al_l[crow(r, hi)]; } } while (0)
    f32x16 pA0, pA1, pB0, pB1; float mnA, mnB, alA, alB; bf16x8 pa0, pa1, pa2, pa3; const int NT = seq / KVBLK;
    sr_[SE].vs0 = ld8(&Vh[(long)(sr) * LDK + sc]); sr_[SE].vs1 = ld8(&Vh[(long)(32 + sr) * LDK + sc]);
    asm volatile("s_waitcnt vmcnt(2)" ::: "memory");
    { int kc = sc * 2; *(bf16x8*)((char*)K_lds + KSWZ(sr, kc)) = sr_[SE].ks0; *(bf16x8*)((char*)K_lds + KSWZ(32 + sr, kc)) = sr_[SE].ks1; } __syncthreads();
    qkt(pA0, pA1, K_lds, qr, r32, hi); partialSM(pA0, pA1, m_reg, mnA, alA);
    asm volatile("s_waitcnt vmcnt(0)" ::: "memory");
    *(bf16x8*)((char*)V_lds + vst0) = sr_[SE].vs0; *(bf16x8*)((char*)V_lds + vst1) = sr_[SE].vs1;
    SLOAD(SO, KVBLK); if (2 < NT) SLOAD(SE, 2 * KVBLK);
    SWAIT(); SWRITE(1, SO); __syncthreads();
    for (int j = 1; j + 1 < NT; j += 2) {
        SBAR(); qkt(pB0, pB1, (bf16_t*)((char*)K_lds + SHM_K), qr, r32, hi);
        finishSM(pA0, pA1, alA, l_reg, pa0, pa1, pa2, pa3); SBAR();
        SLOAD(SO, (j + 2) * KVBLK); SBAR();
        pv_d0(o, vb0, pa0, pa1, pa2, pa3); partialSM(pB0, pB1, m_reg, mnB, alB);
        __syncthreads(); SWAIT(); SWRITE(0, SE);
        RESC(alB); __syncthreads();
        SBAR(); qkt(pA0, pA1, K_lds, qr, r32, hi);
        finishSM(pB0, pB1, alB, l_reg, pa0, pa1, pa2, pa3); SBAR();
        if (j + 3 < NT) SLOAD(SE, (j + 3) * KVBLK); SBAR();
        pv_d0(o, vb0 + (int)SHM_V, pa0, pa1, pa2, pa3); partialSM(pA0, pA1, m_reg, mnA, alA);
        __syncthreads(); SWAIT(); SWRITE(1, SO);
        RESC(alA); __syncthreads();
    }
    SBAR(); qkt(pB0, pB1, (bf16_t*)((char*)K_lds + SHM_K), qr, r32, hi);
    finishSM(pA0, pA1, alA, l_reg, pa0, pa1, pa2, pa3); SBAR();
    pv_d0(o, vb0, pa0, pa1, pa2, pa3); partialSM(pB0, pB1, m_reg, mnB, alB);
    __syncthreads(); RESC(alB);
    finishSM(pB0, pB1, alB, l_reg, pa0, pa1, pa2, pa3); SBAR();
    pv_d0(o, vb0 + (int)SHM_V, pa0, pa1, pa2, pa3);
    if (hi == 0) li_l[r32] = l_reg; asm volatile("s_waitcnt lgkmcnt(0)" ::: "memory");
    float rli[16];
#pragma unroll
    for (int r = 0; r < 16; ++r) rli[r] = __builtin_amdgcn_rcpf(li_l[crow(r, hi)]);
    unsigned char* Ow = Ob + (long)(wid * QBLK) * LDO8;
#pragma unroll
    for (int r = 0; r < 16; ++r) { int orow = crow(r, hi);
        for (int d0 = 0; d0 < 4; ++d0) { const float v = o[d0][r] * (rli[r] * 64.0f); Ow[(long)orow * LDO8 + d0 * 32 + r32] = (unsigned char)(__builtin_amdgcn_cvt_pk_fp8_f32(v, v, 0, false) & 0xff); } }
    __syncthreads();
#undef SLOAD
#undef SWRITE
#undef SWAIT
#undef RESC
}
#undef KSWZ
#undef SBAR
}

__device__ __forceinline__ void tr_desc(const Params& p, int r, const float*& src, int& ld, unsigned char*& dst, int& pitch, int& f8) {
    unsigned char* ws = p.ws;
    constexpr int I0 = 32 * 145, I1 = 32 * 64, I2 = 32 * 64, I3 = 4 * 64, I4 = 16 * 32 * 64;
    f8 = 0;
    if (r < I0) { const int kb = r / 145, nb = r % 145, dn0 = nb * 32; const int sc = dn0 < 1536 ? 3104 + dn0 : (dn0 < 4608 ? dn0 - 1536 : 3072);
        src = p.in[I_WIN] + (size_t)(kb * 64) * 4640 + sc; ld = 4640;
        if (dn0 < 1536 || dn0 >= 3584) { const int r8 = dn0 < 1536 ? dn0 : dn0 - 2048; dst = ws + WS_WIN8 + (size_t)r8 * 2048 + kb * 64; pitch = 2048; f8 = 1; }
        else { dst = ws + WS_WIN + ((size_t)dn0 * 2048 + kb * 64) * 2; pitch = 4096; } return; } r -= I0;
    if (r < I1) { const int kb = r / 64, nb = r % 64;
        src = p.in[I_WOUT] + (size_t)(kb * 64) * 2048 + nb * 32; ld = 2048;
        if (kb >= 16) { dst = ws + WS_WOUT8 + (size_t)(nb * 32) * 1024 + (kb - 16) * 64; pitch = 1024; f8 = 1; }
        else { dst = ws + WS_WOUT + ((size_t)(nb * 32) * 2048 + kb * 64) * 2; pitch = 4096; } return; } r -= I1;
    if (r < I2) { const int kb = r / 64, nb = r % 64;
        src = p.in[I_WPG] + (size_t)(kb * 64) * 2048 + nb * 32; ld = 2048; dst = ws + WS_WPG + (size_t)(nb * 32) * 2048 + kb * 64; pitch = 2048; f8 = 1; return; } r -= I2;
    if (r < I3) { const int kb = r / 64, nb = r % 64;
        src = p.in[I_WPP] + (size_t)(kb * 64) * 2048 + nb * 32; ld = 2048; dst = ws + WS_WPP + ((size_t)(nb * 32) * 256 + kb * 64) * 2; pitch = 512; return; } r -= I3;
    f8 = 1;
    if (r < I4) { const int e = r / 2048, q = r % 2048, kb = q / 64, nb = q % 64, dn0 = nb * 32, t = dn0 >> 8, hlf = (dn0 >> 7) & 1, j0 = dn0 & 127;
        src = (hlf ? p.in[I_WU] : p.in[I_WG]) + (size_t)e * 2048 * 1024 + (size_t)(kb * 64) * 1024 + t * 128 + j0; ld = 1024;
        dst = ws + WS_WGU + (size_t)(e * 2048 + dn0) * 2048 + kb * 64; pitch = 2048; return; } r -= I4;
    { const int e = r / 1024, q = r % 1024, kb = q / 64, nb = q % 64;
        src = p.in[I_WD] + (size_t)e * 1024 * 2048 + (size_t)(kb * 64) * 2048 + nb * 32; ld = 2048; dst = ws + WS_WDN + (size_t)(e * 2048 + nb * 32) * 1024 + kb * 64; pitch = 1024; }
}
constexpr int TR_BUF = 8 * 1040;
__device__ __forceinline__ void tr_loop(const Params& p, LAS unsigned char* scr, int lane_in, int first, int end, int stride) {
    if (first >= end) return;
    int lane = lane_in; asm volatile("" : "+v"(lane));
    const int lr = lane >> 3, lc = (lane & 7) * 4;
    const float* src; int ld; unsigned char* dst; int pitch, f8;
    unsigned char* dst1; int pitch1, f81;
#define TR_ISSUE(boff, SRC, LD) do { _Pragma("unroll") for (int i = 0; i < 8; ++i) \
        __builtin_amdgcn_global_load_lds((const unsigned*)((SRC) + (size_t)(8 * i + lr) * (LD) + lc), (LAS unsigned*)(scr + (boff) + i * 1040), 16, 0, 2); } while (0)
    tr_desc(p, first, src, ld, dst, pitch, f8);
    TR_ISSUE(0, src, ld);
    { const int i1 = first + stride < end ? first + stride : first; tr_desc(p, i1, src, ld, dst1, pitch1, f81); TR_ISSUE(TR_BUF, src, ld); }
    int boff = 0;
    for (int it = first; it < end; it += stride) {
        if (it == first) asm volatile("s_waitcnt vmcnt(8)" ::: "memory"); else asm volatile("s_waitcnt vmcnt(10)" ::: "memory");
        float v[32];
        if (f8) {
            const LAS float* s_ = (const LAS float*)(scr + boff) + (2 * (lane & 3)) * 260 + (lane >> 2);
#pragma unroll
            for (int j = 0; j < 2; ++j)
#pragma unroll
                for (int i = 0; i < 16; ++i) v[j * 16 + i] = s_[(i >> 3) * 260 + (i & 7) * 32 + 16 * j];
        } else {
            const LAS float* s_ = (const LAS float*)(scr + boff) + (lane & 7) * 260 + (lane >> 3);
#pragma unroll
            for (int j = 0; j < 4; ++j)
#pragma unroll
                for (int i = 0; i < 8; ++i) v[j * 8 + i] = s_[i * 32 + 8 * j];
        }
        LDS_WAIT(); asm volatile("" ::: "memory");
        { int i2 = it + 2 * stride; if (i2 >= end) i2 = it + stride < end ? it + stride : it;
          const float* src2; int ld2; unsigned char* dst2; int pitch2, f82;
          tr_desc(p, i2, src2, ld2, dst2, pitch2, f82);
          TR_ISSUE(boff, src2, ld2);
          if (f8) {
              const int c = lane & 3;
#pragma unroll
              for (int j = 0; j < 2; ++j) { const int n = (lane >> 2) + 16 * j; const float* w_ = v + 16 * j;
                  u32x4 o; o.x = pk4_fp8(w_[0] * 8.f, w_[1] * 8.f, w_[2] * 8.f, w_[3] * 8.f); o.y = pk4_fp8(w_[4] * 8.f, w_[5] * 8.f, w_[6] * 8.f, w_[7] * 8.f);
                  o.z = pk4_fp8(w_[8] * 8.f, w_[9] * 8.f, w_[10] * 8.f, w_[11] * 8.f); o.w = pk4_fp8(w_[12] * 8.f, w_[13] * 8.f, w_[14] * 8.f, w_[15] * 8.f);
                  __builtin_nontemporal_store(o, (u32x4*)(dst + (size_t)n * pitch + 16 * c)); }
          } else {
              const int c = lane & 7;
#pragma unroll
              for (int j = 0; j < 4; ++j) { const int n = (lane >> 3) + 8 * j; const float* w_ = v + 8 * j;
                  u32x4 o; o.x = cvt_pk_bf16(w_[0], w_[1]); o.y = cvt_pk_bf16(w_[2], w_[3]); o.z = cvt_pk_bf16(w_[4], w_[5]); o.w = cvt_pk_bf16(w_[6], w_[7]);
                  *(u32x4*)(dst + (size_t)n * pitch + 16 * c) = o; }
          }
          dst = dst1; pitch = pitch1; f8 = f81; dst1 = dst2; pitch1 = pitch2; f81 = f82; }
        boff ^= TR_BUF;
    }
    VM_WAIT();
#undef TR_ISSUE
}
constexpr int TR_SMALL = 32 * 145 + 32 * 64 + 32 * 64 + 4 * 64;
constexpr int TR_ALL = TR_SMALL + 16 * 32 * 64 + 16 * 16 * 64;
__device__ __forceinline__ void phase0(const Params& p, LAS unsigned char* lds, int gw, int NGW, int wave, int lane) {
    unsigned char* ws = p.ws;
    tr_loop(p, lds + wave * (2 * TR_BUF), lane, gw, TR_SMALL, NGW);
    const size_t gt = (size_t)gw * 64 + lane, GT = (size_t)NGW * 64;
#define CVT_PASS(SRC, DST, N8) do { const float* x_ = (SRC); bf16_t* xb_ = (DST); \
      for (size_t i = gt; i < (size_t)(N8); i += 4 * GT) { f32x4 a_[4], b_[4]; \
          _Pragma("unroll") for (int u = 0; u < 4; ++u) { const size_t k_ = i + u * GT; a_[u] = __builtin_nontemporal_load((const f32x4*)(x_ + k_ * 8)); b_[u] = __builtin_nontemporal_load((const f32x4*)(x_ + k_ * 8 + 4)); } \
          _Pragma("unroll") for (int u = 0; u < 4; ++u) { const size_t k_ = i + u * GT; u32x4 w_; w_.x = cvt_pk_bf16(a_[u][0], a_[u][1]); w_.y = cvt_pk_bf16(a_[u][2], a_[u][3]); w_.z = cvt_pk_bf16(b_[u][0], b_[u][1]); w_.w = cvt_pk_bf16(b_[u][2], b_[u][3]); *(u32x4*)(xb_ + k_ * 8) = w_; } } } while (0)
    static_assert(((size_t)NTOK * 256 / 8) % (4 * 131072) == 0, "conversion batches assume a 256 x 512 grid");
    CVT_PASS(p.in[I_P], (bf16_t*)(ws + WS_PB), (size_t)NTOK * 256 / 8);
#undef CVT_PASS
    { constexpr int WROW = 4096 + 16; const float* win = p.in[I_WIN]; const float* x = p.in[I_X]; bf16_t* xb = (bf16_t*)(ws + WS_RB); float* gates = (float*)(ws + WS_GATES);
      const int fr = lane & 15, fq = lane >> 4;
      __syncthreads();
      for (int i0 = threadIdx.x; i0 < 2048 * 8; i0 += 8 * 512) {
          f32x4 w[8];
#pragma unroll
          for (int u = 0; u < 8; ++u) { const int i = i0 + u * 512, k = i >> 3, c4 = i & 7; w[u] = *(const f32x4*)(win + (size_t)k * 4640 + 3072 + c4 * 4); }
#pragma unroll
          for (int u = 0; u < 8; ++u) { const int i = i0 + u * 512, k = i >> 3, c4 = i & 7;
#pragma unroll
              for (int j = 0; j < 4; ++j) *(LAS bf16_t*)(lds + (c4 * 4 + j) * WROW + k * 2) = (bf16_t)f2bf(w[u][j]); } }
      __syncthreads();
      for (int task = gw; task < NTOK / 16; task += NGW) {
          const int row0 = task * 16; const float* xp = x + (size_t)(row0 + fr) * DM + fq * 8; bf16_t* xo = xb + (size_t)(row0 + fr) * DM + fq * 8; unsigned char* x8o = ws + WS_RC + (size_t)(row0 + fr) * DM + fq * 8;
          const LAS unsigned char* b0p = lds + fr * WROW + fq * 16; const LAS unsigned char* b1p = b0p + 16 * WROW;
          f32x4 acc0 = {0.f, 0.f, 0.f, 0.f}, acc1 = {0.f, 0.f, 0.f, 0.f};
          f32x4 la[8][2], lb2[8][2];
#define X_LOAD(BUF, blk) do { _Pragma("unroll") for (int i_ = 0; i_ < 8; ++i_) { BUF[i_][0] = __builtin_nontemporal_load((const f32x4*)(xp + ((blk) * 8 + i_) * 32)); BUF[i_][1] = __builtin_nontemporal_load((const f32x4*)(xp + ((blk) * 8 + i_) * 32 + 4)); } } while (0)
#define X_PROC(BUF, blk) do { _Pragma("unroll") for (int i_ = 0; i_ < 8; ++i_) { const int ks = (blk) * 8 + i_; const f32x4 lo = BUF[i_][0], hi = BUF[i_][1]; \
              u32x4 w; w.x = cvt_pk_bf16(lo[0], lo[1]); w.y = cvt_pk_bf16(lo[2], lo[3]); w.z = cvt_pk_bf16(hi[0], hi[1]); w.w = cvt_pk_bf16(hi[2], hi[3]); \
              *(u32x4*)(xo + ks * 32) = w; \
              { const f32x4 lo8 = lo * 8.f, hi8 = hi * 8.f; u32x2 w8; w8.x = pk4_fp8(lo8[0], lo8[1], lo8[2], lo8[3]); w8.y = pk4_fp8(hi8[0], hi8[1], hi8[2], hi8[3]); *(u32x2*)(x8o + ks * 32) = w8; } \
              const bf16x8 a = __builtin_bit_cast(bf16x8, w), b0 = *(const LAS bf16x8*)(b0p + ks * 64), b1 = *(const LAS bf16x8*)(b1p + ks * 64); \
              acc0 = __builtin_amdgcn_mfma_f32_16x16x32_bf16(a, b0, acc0, 0, 0, 0); acc1 = __builtin_amdgcn_mfma_f32_16x16x32_bf16(a, b1, acc1, 0, 0, 0); } } while (0)
          X_LOAD(la, 0);
#pragma unroll 1
          for (int blk = 0; blk < 8; blk += 2) {
              X_LOAD(lb2, blk + 1);
              X_PROC(la, blk);
              if (blk + 2 < 8) X_LOAD(la, blk + 2);
              X_PROC(lb2, blk + 1);
          }
#undef X_LOAD
#undef X_PROC
#pragma unroll
          for (int r = 0; r < 4; ++r) { float* gp = gates + (size_t)(row0 + 4 * fq + r) * 32 + fr; gp[0] = acc0[r]; gp[16] = acc1[r]; }
      }
      __syncthreads(); }
    { float* tab = (float*)(ws + WS_ROPE);
      for (size_t i = gt; i < 2048; i += GT) { const int pos = (int)i >> 5, f = (int)i & 31; const float inv = powf(10000.0f, -(float)f / 32.0f); const float ang = (float)pos * inv;
          tab[i] = cosf(ang); tab[2048 + i] = sinf(ang); } }
    { float* wrt = (float*)(ws + WS_WRT); const float* wr = p.in[I_WR];
      for (size_t i = gt; i < 16 * 2048; i += GT) { const int e = (int)i >> 11, d = (int)i & 2047; wrt[i] = wr[d * 16 + e]; } }
}

__device__ __forceinline__ void phase_normrope(const Params& p, int gw, int NGW, int lane) {
    bf16_t* proj = (bf16_t*)(p.ws + WS_RA); const float* tab = (const float*)(p.ws + WS_ROPE);
    const int grp = lane >> 4, li = lane & 15;
    const int half = (li >> 2) & 1, f0 = (li & 3) * 8;
    const f32x4 gk0 = *(const f32x4*)(p.in[I_GK] + li * 8), gk1 = *(const f32x4*)(p.in[I_GK] + li * 8 + 4);
    const float g[8] = {gk0[0], gk0[1], gk0[2], gk0[3], gk1[0], gk1[1], gk1[2], gk1[3]};
    constexpr int NIT = NTOK * 2 / 4;
    static_assert(NIT % (4 * 2048) == 0, "normrope batches assume a 256 x 8-wave grid");
    for (int it0 = gw; it0 < NIT; it0 += 4 * NGW) {
        u32x4 raw[4]; f32x4 c0[4], c1[4], s0[4], s1[4]; bf16_t* ptr[4];
#pragma unroll
        for (int u = 0; u < 4; ++u) { const int pair = (it0 + u * NGW) * 4 + grp, tok = pair >> 1, hd = 8 + (pair & 1);
            ptr[u] = proj + (size_t)tok * PJ_LD + hd * 128 + li * 8; raw[u] = *(const u32x4*)ptr[u];
            const int s_ = tok & (SEQ - 1), pos = (li < 8) ? (s_ >> 6) : (s_ & 63); const float* ct = tab + pos * 32 + f0;
            c0[u] = *(const f32x4*)ct; c1[u] = *(const f32x4*)(ct + 4); s0[u] = *(const f32x4*)(ct + 2048); s1[u] = *(const f32x4*)(ct + 2052); }
#pragma unroll
        for (int u = 0; u < 4; ++u) {
            const float x[8] = {bf_lo(raw[u].x), bf_hi(raw[u].x), bf_lo(raw[u].y), bf_hi(raw[u].y), bf_lo(raw[u].z), bf_hi(raw[u].z), bf_lo(raw[u].w), bf_hi(raw[u].w)};
            float ss = 0.f;
#pragma unroll
            for (int j = 0; j < 8; ++j) ss += x[j] * x[j];
            ss = row_sum16(ss);
            const float r = rsqrtf(ss * (1.0f / 128.0f) + NORM_EPS);
            const float cs[8] = {c0[u][0], c0[u][1], c0[u][2], c0[u][3], c1[u][0], c1[u][1], c1[u][2], c1[u][3]};
            const float sn[8] = {s0[u][0], s0[u][1], s0[u][2], s0[u][3], s1[u][0], s1[u][1], s1[u][2], s1[u][3]};
            float o[8];
#pragma unroll
            for (int j = 0; j < 8; ++j) { const float xn = x[j] * r * g[j]; const float pr = lane_xor4(xn, lane); o[j] = xn * cs[j] + (half ? pr : -pr) * sn[j]; }
            u32x4 w; w.x = cvt_pk_bf16(o[0], o[1]); w.y = cvt_pk_bf16(o[2], o[3]); w.z = cvt_pk_bf16(o[4], o[5]); w.w = cvt_pk_bf16(o[6], o[7]);
            *(u32x4*)ptr[u] = w; }
    }
}

__device__ __forceinline__ void phase_convsilu(const Params& p, int gw, int NGW, int lane) {
    const bf16_t* proj = (const bf16_t*)(p.ws + WS_RA); bf16_t* qkc = (bf16_t*)(p.ws + WS_RE); const float* convw = p.in[I_CONVW];
    for (int task = gw; task < NTOK / 16 * 2; task += NGW) {
        const int half = task & 1, tok0 = (task >> 1) * 16, c0 = half * 512 + lane * 8, s0 = tok0 & (SEQ - 1);
        f32x4 wv[5][2];
#pragma unroll
        for (int j = 0; j < 5; ++j) { wv[j][0] = *(const f32x4*)(convw + j * 1024 + c0); wv[j][1] = *(const f32x4*)(convw + j * 1024 + c0 + 4); }
        const bf16_t* src = proj + (size_t)tok0 * PJ_LD + C_MQ + c0;
        u32x4 rr[20];
#pragma unroll
        for (int j = 0; j < 20; ++j) { const int s = s0 + j - 2; const int sc = s < 0 ? 0 : (s >= SEQ ? SEQ - 1 : s); const u32x4 v = *(const u32x4*)(src + (ptrdiff_t)(sc - s0) * PJ_LD); rr[j] = (s == sc) ? v : (u32x4){0u, 0u, 0u, 0u}; }
#pragma unroll
        for (int i = 0; i < 16; ++i) {
            f32x4 a0 = {0.f, 0.f, 0.f, 0.f}, a1 = {0.f, 0.f, 0.f, 0.f};
#pragma unroll
            for (int j = 0; j < 5; ++j) { const u32x4 rw = rr[i + j];
                a0 += wv[j][0] * (f32x4){bf_lo(rw.x), bf_hi(rw.x), bf_lo(rw.y), bf_hi(rw.y)}; a1 += wv[j][1] * (f32x4){bf_lo(rw.z), bf_hi(rw.z), bf_lo(rw.w), bf_hi(rw.w)}; }
            const f32x4 t0 = a0 * -1.4426950408889634f, t1 = a1 * -1.4426950408889634f; f32x4 e0, e1;
#pragma unroll
            for (int q = 0; q < 4; ++q) { e0[q] = __builtin_amdgcn_exp2f(t0[q]); e1[q] = __builtin_amdgcn_exp2f(t1[q]); }
            const f32x4 d0 = e0 + 1.0f, d1 = e1 + 1.0f; f32x4 s0_, s1_;
#pragma unroll
            for (int q = 0; q < 4; ++q) { s0_[q] = __builtin_amdgcn_rcpf(d0[q]); s1_[q] = __builtin_amdgcn_rcpf(d1[q]); }
            a0 = a0 * s0_; a1 = a1 * s1_;
            u32x4 o; o.x = cvt_pk_bf16(a0[0], a0[1]); o.y = cvt_pk_bf16(a0[2], a0[3]); o.z = cvt_pk_bf16(a1[0], a1[1]); o.w = cvt_pk_bf16(a1[2], a1[3]);
            *(u32x4*)(qkc + (size_t)(tok0 + i) * 1024 + c0) = o; }
    }
}


__device__ __forceinline__ void phase_gates(const Params& p, LAS unsigned char* lds, int gw, int NGW, int lane) {
    const bf16_t* xb = (const bf16_t*)(p.ws + WS_RB); const bf16_t* wg = (const bf16_t*)(p.ws + WS_WIN) + (size_t)4608 * 2048; float* gates = (float*)(p.ws + WS_GATES);
    const int fr = lane & 15, fq = lane >> 4;
    constexpr int WROW = 4096 + 16;
    __syncthreads();
    for (int i = threadIdx.x; i < 32 * 256; i += 512) { const int row = i >> 8, pc = i & 255; *(LAS u32x4*)(lds + row * WROW + pc * 16) = *(const u32x4*)(wg + (size_t)row * DM + pc * 8); }
    __syncthreads();
    for (int task = gw; task < NTOK / 16; task += NGW) {
        const int row0 = task * 16;
        const bf16_t* ap = xb + (size_t)(row0 + fr) * DM + fq * 8;
        const LAS unsigned char* b0p = lds + fr * WROW + fq * 16; const LAS unsigned char* b1p = b0p + 16 * WROW;
        f32x4 acc0 = {0.f, 0.f, 0.f, 0.f}, acc1 = {0.f, 0.f, 0.f, 0.f};
#pragma unroll 8
        for (int ks = 0; ks < 64; ++ks) { const bf16x8 a = *(const bf16x8*)(ap + ks * 32), b0 = *(const LAS bf16x8*)(b0p + ks * 64), b1 = *(const LAS bf16x8*)(b1p + ks * 64);
            acc0 = __builtin_amdgcn_mfma_f32_16x16x32_bf16(a, b0, acc0, 0, 0, 0); acc1 = __builtin_amdgcn_mfma_f32_16x16x32_bf16(a, b1, acc1, 0, 0, 0); }
#pragma unroll
        for (int r = 0; r < 4; ++r) { float* gp = gates + (size_t)(row0 + 4 * fq + r) * 32 + fr; gp[0] = acc0[r]; gp[16] = acc1[r]; }
    }
    __syncthreads();
}

__device__ __forceinline__ void phase_mlstm_naive(const Params& p, LAS unsigned char* lds) {
    const bf16_t* proj = (const bf16_t*)(p.ws + WS_RA); const float* gates = (const float*)(p.ws + WS_GATES); bf16_t* hdir = (bf16_t*)p.out;
    const float* convw = p.in[I_CONVW];
    LAS float* qs = (LAS float*)lds; LAS float* ks = qs + 4096; LAS float* vs = ks + 4096; LAS float* gi = vs + 8192; LAS float* gf = gi + 64;
    const int tid = threadIdx.x;
    for (int job = blockIdx.x; job < 256; job += gridDim.x) {
        const int dir = job & 1, h = (job >> 1) & 7, b = job >> 4;
        float C[64], n[64];
#pragma unroll
        for (int d = 0; d < 64; ++d) { C[d] = 0.f; n[d] = 0.f; }
        for (int ci = 0; ci < 32; ++ci) {
            const int t0 = (dir ? 31 - ci : ci) * 64;
            __syncthreads();
            for (int e = tid; e < 8192; e += 512) { const int which = e >> 12, tl = (e >> 6) & 63, c = e & 63, ch = which * 512 + h * 64 + c;
                float a = 0.f;
#pragma unroll
                for (int j = 0; j < 5; ++j) { const int tt = t0 + tl + j - 2; if (tt >= 0 && tt < SEQ) a += convw[j * 1024 + ch] * bf2f(proj[(size_t)(b * SEQ + tt) * PJ_LD + C_MQ + ch]); }
                const float v = siluf_(a);
                if (which == 0) qs[tl * 64 + c] = v * 0.125f; else ks[tl * 64 + c] = v; }
            for (int e = tid; e < 8192; e += 512) { const int tl = e >> 7, c = e & 127; vs[e] = bf2f(proj[(size_t)(b * SEQ + t0 + tl) * PJ_LD + C_MV + h * 128 + c]); }
            if (tid < 64) { const size_t tok = (size_t)b * SEQ + t0 + tid;
                const float gpi = gates[tok * 32 + dir * 16 + h] + p.in[I_BI][dir * 8 + h], gpf = gates[tok * 32 + dir * 16 + 8 + h] + p.in[I_BF][dir * 8 + h];
                gi[tid] = __expf(gpi); gf[tid] = 1.0f / (1.0f + __expf(-gpf)); }
            __syncthreads();
            if (tid < 128) {
                for (int r = 0; r < 64; ++r) { const int tl = dir ? 63 - r : r;
                    const float f = gf[tl], ig = gi[tl], vv = vs[tl * 128 + tid];
                    float num = 0.f, den = 0.f;
#pragma unroll
                    for (int d = 0; d < 64; ++d) { const float kd = ks[tl * 64 + d] * ig, qd = qs[tl * 64 + d];
                        n[d] = f * n[d] + kd; C[d] = f * C[d] + kd * vv; num += qd * C[d]; den += qd * n[d]; }
                    const float hv = num / fmaxf(fabsf(den), 1.0f);
                    hdir[((size_t)dir * NTOK + (size_t)b * SEQ + t0 + tl) * 1024 + h * 128 + tid] = (bf16_t)f2bf(hv); }
            }
        }
    }
}


namespace ml {
constexpr int LD = 72;
constexpr int LDV = 152;
constexpr int O_QS = 0, O_KS = 9216, O_SP = 18432, O_CT = 27648, O_VR = 48384, O_VEC = 67840;
__device__ __forceinline__ bf16x8 frag(const LAS unsigned char* lds, int arr, int row0, int ks, int lb) { return *(const LAS bf16x8*)(lds + (arr + row0 * (LD * 2) + ks * 64) + lb); }
__device__ __forceinline__ s16x4 trr(int addr) { s16x4 r; asm volatile("ds_read_b64_tr_b16 %0, %1" : "=&v"(r) : "v"(addr) : "memory"); return r; }
#define ML_PK(L, H) (bf16x8){L[0], L[1], L[2], L[3], H[0], H[1], H[2], H[3]}
#define ML_LGKM0() do { asm volatile("s_waitcnt lgkmcnt(0)" ::: "memory"); __builtin_amdgcn_sched_barrier(0); } while (0)
}
__device__ __forceinline__ void phase_mlstm(const Params& p, LAS unsigned char* lds) {
    using namespace ml;
    const bf16_t* proj = (const bf16_t*)(p.ws + WS_RA); const float* gates = (const float*)(p.ws + WS_GATES); bf16_t* hdir = (bf16_t*)p.out;
    const bf16_t* qkc = (const bf16_t*)(p.ws + WS_RE);
    LAS bf16_t* Qs = (LAS bf16_t*)(lds + O_QS); LAS bf16_t* Ks = (LAS bf16_t*)(lds + O_KS);
    LAS bf16_t* Sp = (LAS bf16_t*)(lds + O_SP); LAS bf16_t* CT = (LAS bf16_t*)(lds + O_CT); LAS bf16_t* Vr = (LAS bf16_t*)(lds + O_VR);
    LAS float* EB = (LAS float*)(lds + O_VEC); LAS float* EA = EB + 2048; LAS float* E63 = EA + 2048; LAS float* den = E63 + 32;
    const int tid = threadIdx.x, lane = tid & 63, wave = __builtin_amdgcn_readfirstlane(tid >> 6), fr = lane & 15, fq = lane >> 4;
    const int lds_base = (int)(unsigned)(__UINTPTR_TYPE__)lds;
    const int stok = tid >> 3, spc = tid & 7;
    for (int job = blockIdx.x; job < 256; job += gridDim.x) {
        const int dir = job & 1, h = (job >> 1) & 7, b = job >> 4;
        const float bi = p.in[I_BI][dir * 8 + h], bfg = p.in[I_BF][dir * 8 + h];
        __syncthreads();
#pragma unroll
        for (int k = 0; k < 4; ++k) { const int cj = wave + 8 * k, t0g = (dir ? 31 - cj : cj) * 64, tl = dir ? 63 - lane : lane; const size_t tok = (size_t)b * SEQ + t0g + tl;
            const float xf = gates[tok * 32 + dir * 16 + 8 + h] + bfg, xi = gates[tok * 32 + dir * 16 + h] + bi;
            const float lf = xf >= 0.f ? -log1pf(expf(-xf)) : xf - log1pf(expf(xf));
            float bc = lf;
#pragma unroll
            for (int o = 1; o < 64; o <<= 1) { const float t = __shfl_up(bc, o); if (lane >= o) bc += t; }
            EB[cj * 64 + lane] = expf(bc); EA[cj * 64 + lane] = expf(xi - bc); if (lane == 63) E63[cj] = expf(bc); }
        for (int i = tid; i < 144 * LD / 2; i += 512) ((LAS unsigned*)CT)[i] = 0u;
        for (int i = tid; i < 64 * 16; i += 512) Vr[(i >> 4) * LDV + 128 + (i & 15)] = (bf16_t)(((i & 15) == 0) ? 0x3F80 : 0);
        f32x4 Cacc[5];
#pragma unroll
        for (int i = 0; i < 5; ++i) Cacc[i] = (f32x4){0.f, 0.f, 0.f, 0.f};
        u32x4 rq, rk, va, vb_, rqn, rkn, van, vbn;
#define ML_LOAD(cidx, RQ, RK, VA, VB) do { const int t0n_ = (dir ? 31 - (cidx) : (cidx)) * 64; const size_t tk_ = (size_t)(b * SEQ + t0n_ + stok); \
            const bf16_t* qs_ = qkc + tk_ * 1024 + h * 64 + spc * 8; RQ = *(const u32x4*)qs_; RK = *(const u32x4*)(qs_ + 512); \
            const bf16_t* vs_ = proj + tk_ * PJ_LD + C_MV + h * 128 + spc * 16; VA = *(const u32x4*)vs_; VB = *(const u32x4*)(vs_ + 8); } while (0)
        ML_LOAD(0, rq, rk, va, vb_);
        __syncthreads();
        for (int ci = 0; ci < 32; ++ci) {
            const int t0 = (dir ? 31 - ci : ci) * 64;
            int lb = fr * (LD * 2) + fq * 16; asm volatile("" : "+v"(lb));
            int tk = lds_base + O_KS + (8 * fq + (fr >> 2)) * (LD * 2) + (fr & 3) * 8; asm volatile("" : "+v"(tk));
            int tv = lds_base + O_VR + (8 * fq + (fr >> 2)) * (LDV * 2) + (fr & 3) * 8; asm volatile("" : "+v"(tv));
            { const int cn = ci + 1 < 32 ? ci + 1 : ci; ML_LOAD(cn, rqn, rkn, van, vbn); }
            { const int r = dir ? 63 - stok : stok; const float sq = 0.125f * EB[ci * 64 + r], sk = EA[ci * 64 + r];
              const unsigned qw[4] = {rq.x, rq.y, rq.z, rq.w}, kw[4] = {rk.x, rk.y, rk.z, rk.w};
              u32x4 oq, ok;
              oq.x = cvt_pk_bf16(bf_lo(qw[0]) * sq, bf_hi(qw[0]) * sq); oq.y = cvt_pk_bf16(bf_lo(qw[1]) * sq, bf_hi(qw[1]) * sq); oq.z = cvt_pk_bf16(bf_lo(qw[2]) * sq, bf_hi(qw[2]) * sq); oq.w = cvt_pk_bf16(bf_lo(qw[3]) * sq, bf_hi(qw[3]) * sq);
              ok.x = cvt_pk_bf16(bf_lo(kw[0]) * sk, bf_hi(kw[0]) * sk); ok.y = cvt_pk_bf16(bf_lo(kw[1]) * sk, bf_hi(kw[1]) * sk); ok.z = cvt_pk_bf16(bf_lo(kw[2]) * sk, bf_hi(kw[2]) * sk); ok.w = cvt_pk_bf16(bf_lo(kw[3]) * sk, bf_hi(kw[3]) * sk);
              *(LAS u32x4*)(Qs + r * LD + spc * 8) = oq; *(LAS u32x4*)(Ks + r * LD + spc * 8) = ok;
              *(LAS u32x4*)(Vr + r * LDV + spc * 16) = va; *(LAS u32x4*)(Vr + r * LDV + spc * 16 + 8) = vb_; }
            __syncthreads();
#pragma unroll
            for (int q = 0; q < 2; ++q) { const int idx = 2 * wave + q, st = idx >> 2, tt = idx & 3;
                f32x4 d = {0.f, 0.f, 0.f, 0.f};
                if (st <= tt) {
#pragma unroll
                    for (int ks = 0; ks < 2; ++ks) d = __builtin_amdgcn_mfma_f32_16x16x32_bf16(frag(lds, O_KS, st * 16, ks, lb), frag(lds, O_QS, tt * 16, ks, lb), d, 0, 0, 0);
                    if (st == tt) {
#pragma unroll
                        for (int rg_ = 0; rg_ < 4; ++rg_) if (4 * fq + rg_ > fr) d[rg_] = 0.f; } }
                u32x2 w; w.x = cvt_pk_bf16(d[0], d[1]); w.y = cvt_pk_bf16(d[2], d[3]);
                *(LAS u32x2*)(Sp + (tt * 16 + fr) * LD + st * 16 + 4 * fq) = w; }
            __syncthreads();
            f32x4 nacc[5];
            { const int tt = wave & 3, ka_ = tk + tt * 32;
              const bf16x8 s0 = frag(lds, O_SP, tt * 16, 0, lb), s1 = frag(lds, O_SP, tt * 16, 1, lb), q0 = frag(lds, O_QS, tt * 16, 0, lb), q1 = frag(lds, O_QS, tt * 16, 1, lb);
              const s16x4 kl0 = trr(ka_), kh0 = trr(ka_ + 4 * LD * 2), kl1 = trr(ka_ + 32 * LD * 2), kh1 = trr(ka_ + 36 * LD * 2);
              s16x4 vl0[5], vh0[5], vl1[5], vh1[5]; bf16x8 c0[5], c1[5];
#pragma unroll
              for (int i = 0; i < 5; ++i) { if (i < 4 || wave < 4) { const int vt = (wave + 8 * i) >> 2, va_ = tv + vt * 32;
                  vl0[i] = trr(va_); vh0[i] = trr(va_ + 4 * LDV * 2); vl1[i] = trr(va_ + 32 * LDV * 2); vh1[i] = trr(va_ + 36 * LDV * 2);
                  c0[i] = frag(lds, O_CT, vt * 16, 0, lb); c1[i] = frag(lds, O_CT, vt * 16, 1, lb); } }
              ML_LGKM0();
              const bf16x8 ka0 = ML_PK(kl0, kh0), ka1 = ML_PK(kl1, kh1);
              const float e63 = E63[ci];
#pragma unroll
              for (int i = 0; i < 5; ++i) { if (i < 4 || wave < 4) nacc[i] = __builtin_amdgcn_mfma_f32_16x16x32_bf16(ML_PK(vl0[i], vh0[i]), s0, (f32x4){0.f, 0.f, 0.f, 0.f}, 0, 0, 0); }
#pragma unroll
              for (int i = 0; i < 5; ++i) { if (i < 4 || wave < 4) nacc[i] = __builtin_amdgcn_mfma_f32_16x16x32_bf16(ML_PK(vl1[i], vh1[i]), s1, nacc[i], 0, 0, 0); }
#pragma unroll
              for (int i = 0; i < 5; ++i) { if (i < 4 || wave < 4) nacc[i] = __builtin_amdgcn_mfma_f32_16x16x32_bf16(c0[i], q0, nacc[i], 0, 0, 0); }
#pragma unroll
              for (int i = 0; i < 5; ++i) { if (i < 4 || wave < 4) nacc[i] = __builtin_amdgcn_mfma_f32_16x16x32_bf16(c1[i], q1, nacc[i], 0, 0, 0); }
#pragma unroll
              for (int i = 0; i < 5; ++i) { if (i < 4 || wave < 4) Cacc[i] = __builtin_amdgcn_mfma_f32_16x16x32_bf16(ka0, ML_PK(vl0[i], vh0[i]), Cacc[i], 0, 0, 0); }
#pragma unroll
              for (int i = 0; i < 5; ++i) { if (i < 4 || wave < 4) Cacc[i] = __builtin_amdgcn_mfma_f32_16x16x32_bf16(ka1, ML_PK(vl1[i], vh1[i]), Cacc[i], 0, 0, 0); }
#pragma unroll
              for (int i = 0; i < 5; ++i) { if (i < 4 || wave < 4) Cacc[i] = Cacc[i] * e63; }
            }
            if (wave < 4 && fq == 0) den[wave * 16 + fr] = nacc[4][0];
            __syncthreads();
#pragma unroll
            for (int i = 0; i < 4; ++i) { const int idx = wave + 8 * i, vt = idx >> 2, tt = idx & 3, t = tt * 16 + fr, tl = dir ? 63 - t : t;
                const float sc = __builtin_amdgcn_rcpf(fmaxf(fabsf(den[t]), 1.0f));
                u32x2 w; w.x = cvt_pk_bf16(nacc[i][0] * sc, nacc[i][1] * sc); w.y = cvt_pk_bf16(nacc[i][2] * sc, nacc[i][3] * sc);
                *(u32x2*)(hdir + ((size_t)dir * NTOK + (size_t)b * SEQ + t0 + tl) * 1024 + h * 128 + vt * 16 + 4 * fq) = w; }
#pragma unroll
            for (int i = 0; i < 5; ++i) { if (i < 4 || wave < 4) { const int idx = wave + 8 * i, vt = idx >> 2, dt = idx & 3;
                u32x2 w; w.x = cvt_pk_bf16(Cacc[i][0], Cacc[i][1]); w.y = cvt_pk_bf16(Cacc[i][2], Cacc[i][3]);
                *(LAS u32x2*)(CT + (vt * 16 + fr) * LD + dt * 16 + 4 * fq) = w; } }
            rq = rqn; rk = rkn; va = van; vb_ = vbn;
        }
#undef ML_LOAD
    }
    __syncthreads();
}


__device__ __forceinline__ void combine_unit(const Params& p, int tok0, int h, int wave, int lane) {
    const bf16_t* proj = (const bf16_t*)(p.ws + WS_RA); const bf16_t* hdir = (const bf16_t*)p.out; bf16_t* hcat = (bf16_t*)(p.ws + WS_RC);
    int lane_ = lane; asm volatile("" : "+v"(lane_));
    const int grp = lane_ >> 4, li = lane_ & 15;
    const f32x4 g0 = *(const f32x4*)(p.in[I_GM] + h * 128 + li * 8), g1 = *(const f32x4*)(p.in[I_GM] + h * 128 + li * 8 + 4);
    const float g[8] = {g0[0], g0[1], g0[2], g0[3], g1[0], g1[1], g1[2], g1[3]};
#pragma unroll
    for (int half = 0; half < 2; ++half) {
        u32x4 a[4], bb[4], ow[4];
#pragma unroll
        for (int u = 0; u < 4; ++u) { const int tok = tok0 + wave * 32 + (half * 4 + u) * 4 + grp;
            a[u] = __builtin_nontemporal_load((const u32x4*)(hdir + (size_t)tok * 1024 + h * 128 + li * 8)); bb[u] = __builtin_nontemporal_load((const u32x4*)(hdir + ((size_t)NTOK + tok) * 1024 + h * 128 + li * 8));
            ow[u] = __builtin_nontemporal_load((const u32x4*)(proj + (size_t)tok * PJ_LD + C_MO + h * 128 + li * 8)); }
#pragma unroll
        for (int u = 0; u < 4; ++u) { const int tok = tok0 + wave * 32 + (half * 4 + u) * 4 + grp;
            const float s_[8] = {bf_lo(a[u].x) + bf_lo(bb[u].x), bf_hi(a[u].x) + bf_hi(bb[u].x), bf_lo(a[u].y) + bf_lo(bb[u].y), bf_hi(a[u].y) + bf_hi(bb[u].y), bf_lo(a[u].z) + bf_lo(bb[u].z), bf_hi(a[u].z) + bf_hi(bb[u].z), bf_lo(a[u].w) + bf_lo(bb[u].w), bf_hi(a[u].w) + bf_hi(bb[u].w)};
            const float og[8] = {bf_lo(ow[u].x), bf_hi(ow[u].x), bf_lo(ow[u].y), bf_hi(ow[u].y), bf_lo(ow[u].z), bf_hi(ow[u].z), bf_lo(ow[u].w), bf_hi(ow[u].w)};
            float ss = 0.f;
#pragma unroll
            for (int j = 0; j < 8; ++j) ss += s_[j] * s_[j];
            ss = row_sum16(ss);
            const float r = rsqrtf(ss * (1.0f / 128.0f) + NORM_EPS);
            float o[8];
#pragma unroll
            for (int j = 0; j < 8; ++j) o[j] = sigmoidf_(og[j]) * (s_[j] * r * g[j]);
            u32x4 w; w.x = cvt_pk_bf16(o[0], o[1]); w.y = cvt_pk_bf16(o[2], o[3]); w.z = cvt_pk_bf16(o[4], o[5]); w.w = cvt_pk_bf16(o[6], o[7]);
            *(u32x4*)(hcat + (size_t)tok * DM + h * 128 + li * 8) = w; }
    }
}

__device__ __forceinline__ bool attn_unit(int i, int G, int c, int& b, int& hq, int& qb) {
    if (G == 256) { if (i >= 4) return false; const int x = c & 7, w = c >> 3; b = 4 * i + (x >> 1); hq = (x & 1) * 4 + (w >> 3); qb = w & 7; return true; }
    const int u = i * G + c; if (u >= 1024) return false; qb = u & 7; hq = (u >> 3) & 7; b = u >> 6; return true;
}
__device__ __forceinline__ void phase_attention(const Params& p, unsigned char* lds_generic) {
    const bf16_t* proj = (const bf16_t*)(p.ws + WS_RA); bf16_t* hcat = (bf16_t*)(p.ws + WS_RC);
    const int slot = (blockIdx.x >> 3) & 3;
    for (int i = 0;; ++i) {
        { int b, hq, qb; if (!attn_unit(i, gridDim.x, blockIdx.x, b, hq, qb)) break; }
        if (i == slot || (gridDim.x != 256 && i == 0)) {
            { const int wv = __builtin_amdgcn_readfirstlane(threadIdx.x >> 6); __syncthreads();
              if (wv < 4) tr_loop(p, (LAS unsigned char*)lds_generic + wv * (2 * TR_BUF), threadIdx.x & 63, TR_SMALL + blockIdx.x * 4 + wv, TR_ALL, gridDim.x * 4);
              else for (int j = 0;; ++j) { int b, hq, qb; if (!attn_unit(j, gridDim.x, blockIdx.x, b, hq, qb)) break;
                  combine_unit(p, b * SEQ + qb * 256, hq, (wv - 4) * 2, threadIdx.x & 63); combine_unit(p, b * SEQ + qb * 256, hq, (wv - 4) * 2 + 1, threadIdx.x & 63); }
              __syncthreads(); }
        }
        { int b, hq, qb; int ii = i; asm volatile("" : "+s"(ii)); attn_unit(ii, gridDim.x, blockIdx.x, b, hq, qb);
          const int kvh = hq >> 2;
          const bf16_t* Qb = proj + (size_t)(b * SEQ + qb * 256) * PJ_LD + C_AQ + hq * 128;
          const bf16_t* Kh = proj + (size_t)(b * SEQ) * PJ_LD + C_AK + kvh * 128;
          const bf16_t* Vh = proj + (size_t)(b * SEQ) * PJ_LD + C_AV + kvh * 128;
          unsigned char* Ob = p.ws + WS_RE + (size_t)(b * SEQ + qb * 256) * 1024 + hq * 128;
          att::attn_dense_body(Qb, Kh, Vh, Ob, SEQ, (char*)lds_generic, p.in[I_GQ], (const float*)(p.ws + WS_ROPE), qb * 256); }
    }
}
__device__ __forceinline__ void phase_combine(const Params& p, int gw, int NGW, int lane) {
    const bf16_t* proj = (const bf16_t*)(p.ws + WS_RA); const bf16_t* hdir = (const bf16_t*)p.out; bf16_t* hcat = (bf16_t*)(p.ws + WS_RC);
    const int grp = lane >> 4, li = lane & 15;
    constexpr int NIT = NTOK * 8 / 4;
    static_assert(NIT % (4 * 2048) == 0, "combine batches assume a 256 x 8-wave grid");
    for (int it0 = gw; it0 < NIT; it0 += 4 * NGW) {
        u32x4 a[4], bb[4], ow[4];
#pragma unroll
        for (int u = 0; u < 4; ++u) { const int pair = (it0 + u * NGW) * 4 + grp, tok = pair >> 3, h = pair & 7;
            a[u] = *(const u32x4*)(hdir + (size_t)tok * 1024 + h * 128 + li * 8); bb[u] = *(const u32x4*)(hdir + ((size_t)NTOK + tok) * 1024 + h * 128 + li * 8);
            ow[u] = *(const u32x4*)(proj + (size_t)tok * PJ_LD + C_MO + h * 128 + li * 8); }
#pragma unroll
        for (int u = 0; u < 4; ++u) { const int pair = (it0 + u * NGW) * 4 + grp, tok = pair >> 3, h = pair & 7;
            float s[8] = {bf_lo(a[u].x) + bf_lo(bb[u].x), bf_hi(a[u].x) + bf_hi(bb[u].x), bf_lo(a[u].y) + bf_lo(bb[u].y), bf_hi(a[u].y) + bf_hi(bb[u].y), bf_lo(a[u].z) + bf_lo(bb[u].z), bf_hi(a[u].z) + bf_hi(bb[u].z), bf_lo(a[u].w) + bf_lo(bb[u].w), bf_hi(a[u].w) + bf_hi(bb[u].w)};
            const float og[8] = {bf_lo(ow[u].x), bf_hi(ow[u].x), bf_lo(ow[u].y), bf_hi(ow[u].y), bf_lo(ow[u].z), bf_hi(ow[u].z), bf_lo(ow[u].w), bf_hi(ow[u].w)};
            float ss = 0.f;
#pragma unroll
            for (int j = 0; j < 8; ++j) ss += s[j] * s[j];
            ss = row_sum16(ss);
            const float r = rsqrtf(ss * (1.0f / 128.0f) + NORM_EPS);
            const float* g = p.in[I_GM] + h * 128 + li * 8;
            float o[8];
#pragma unroll
            for (int j = 0; j < 8; ++j) o[j] = sigmoidf_(og[j]) * (s[j] * r * g[j]);
            u32x4 w; w.x = cvt_pk_bf16(o[0], o[1]); w.y = cvt_pk_bf16(o[2], o[3]); w.z = cvt_pk_bf16(o[4], o[5]); w.w = cvt_pk_bf16(o[6], o[7]);
            *(u32x4*)(hcat + (size_t)tok * DM + h * 128 + li * 8) = w; }
    }
}

__device__ __forceinline__ void phase_ln1_router(const Params& p, LAS unsigned char* lds, int gw, int NGW, int lane) {
    const bf16_t* y1b = (const bf16_t*)p.out;
    bf16_t* x1b = (bf16_t*)(p.ws + WS_RB); const float* wrt = (const float*)(p.ws + WS_WRT); float* aff = (float*)(p.ws + WS_AFF);
    unsigned char* x1f8 = p.ws + WS_RA;
    const float* g1 = p.in[I_LN1G]; const float* b1 = p.in[I_LN1B];
    constexpr int WROW = 4096 + 16;
    const int fr = lane & 15, fq = lane >> 4;
    __syncthreads();
    for (int i = threadIdx.x; i < 16 * 256; i += 512) { const int row = i >> 8, pc = i & 255; const f32x4 a = *(const f32x4*)(wrt + row * 2048 + pc * 8), c = *(const f32x4*)(wrt + row * 2048 + pc * 8 + 4);
        u32x4 w; w.x = cvt_pk_bf16(a[0], a[1]); w.y = cvt_pk_bf16(a[2], a[3]); w.z = cvt_pk_bf16(c[0], c[1]); w.w = cvt_pk_bf16(c[2], c[3]); *(LAS u32x4*)(lds + row * WROW + pc * 16) = w; }
    __syncthreads();
    for (int rg = gw; rg < NTOK / 16; rg += NGW) {
        const int row0 = rg * 16;
        u32x4 raw[4], rawa[4], rawb[4];
#pragma unroll
        for (int j = 0; j < 4; ++j) { raw[j] = __builtin_nontemporal_load((const u32x4*)(y1b + (size_t)row0 * DM + 8 * lane + 512 * j));
            rawa[j] = __builtin_nontemporal_load((const u32x4*)(y1b + (size_t)(row0 + 1) * DM + 8 * lane + 512 * j)); rawb[j] = __builtin_nontemporal_load((const u32x4*)(y1b + (size_t)(row0 + 2) * DM + 8 * lane + 512 * j)); }
        f32x4 gav[4], gbv[4], bav[4], bbv[4];
#pragma unroll
        for (int j = 0; j < 4; ++j) { gav[j] = *(const f32x4*)(g1 + 8 * lane + 512 * j); gbv[j] = *(const f32x4*)(g1 + 8 * lane + 512 * j + 4); bav[j] = *(const f32x4*)(b1 + 8 * lane + 512 * j); bbv[j] = *(const f32x4*)(b1 + 8 * lane + 512 * j + 4); }
        for (int r = 0; r < 16; ++r) {
            const int rn = r < 13 ? r + 3 : 15;
            u32x4 rawn[4];
#pragma unroll
            for (int j = 0; j < 4; ++j) rawn[j] = __builtin_nontemporal_load((const u32x4*)(y1b + (size_t)(row0 + rn) * DM + 8 * lane + 512 * j));
            f32x4 xa[4], xb_[4];
#pragma unroll
            for (int j = 0; j < 4; ++j) { xa[j] = (f32x4){bf_lo(raw[j].x), bf_hi(raw[j].x), bf_lo(raw[j].y), bf_hi(raw[j].y)}; xb_[j] = (f32x4){bf_lo(raw[j].z), bf_hi(raw[j].z), bf_lo(raw[j].w), bf_hi(raw[j].w)}; }
            f32x4 sv_ = (xa[0] + xb_[0]) + (xa[1] + xb_[1]) + ((xa[2] + xb_[2]) + (xa[3] + xb_[3]));
            const float mean = wave_sum((sv_[0] + sv_[1]) + (sv_[2] + sv_[3])) * (1.0f / DM);
            f32x4 qv_ = {0.f, 0.f, 0.f, 0.f};
#pragma unroll
            for (int j = 0; j < 4; ++j) { xa[j] = xa[j] - mean; xb_[j] = xb_[j] - mean; qv_ += xa[j] * xa[j]; qv_ += xb_[j] * xb_[j]; }
            const float rstd = rsqrtf(wave_sum((qv_[0] + qv_[1]) + (qv_[2] + qv_[3])) * (1.0f / DM) + NORM_EPS);
#pragma unroll
            for (int j = 0; j < 4; ++j) { const f32x4 oa = xa[j] * (gav[j] * rstd) + bav[j], ob = xb_[j] * (gbv[j] * rstd) + bbv[j];
                u32x4 w; w.x = cvt_pk_bf16(oa[0], oa[1]); w.y = cvt_pk_bf16(oa[2], oa[3]); w.z = cvt_pk_bf16(ob[0], ob[1]); w.w = cvt_pk_bf16(ob[2], ob[3]);
                *(u32x4*)(x1b + (size_t)(row0 + r) * DM + 8 * lane + 512 * j) = w;
                const f32x4 oa8 = oa * 8.f, ob8 = ob * 8.f;
                u32x2 w8; w8.x = pk4_fp8(oa8[0], oa8[1], oa8[2], oa8[3]); w8.y = pk4_fp8(ob8[0], ob8[1], ob8[2], ob8[3]);
                *(u32x2*)(x1f8 + (size_t)(row0 + r) * DM + 8 * lane + 512 * j) = w8; }
#pragma unroll
            for (int j = 0; j < 4; ++j) { raw[j] = rawa[j]; rawa[j] = rawb[j]; rawb[j] = rawn[j]; }
        }
        __threadfence_block(); VM_WAIT();
        f32x4 acc = {0.f, 0.f, 0.f, 0.f};
        const bf16_t* ap = x1b + (size_t)(row0 + fr) * DM + fq * 8; const LAS unsigned char* bp = lds + fr * WROW + fq * 16;
        f32x4 acc2 = {0.f, 0.f, 0.f, 0.f};
        { bf16x8 fa[16], fb[16];
#define R_LOAD(BUF, blk) do { _Pragma("unroll") for (int i_ = 0; i_ < 16; ++i_) BUF[i_] = *(const bf16x8*)(ap + ((blk) * 16 + i_) * 32); } while (0)
#define R_PROC(BUF, blk) do { _Pragma("unroll") for (int i_ = 0; i_ < 16; ++i_) { const bf16x8 bw = *(const LAS bf16x8*)(bp + ((blk) * 16 + i_) * 64); if (i_ & 1) acc2 = __builtin_amdgcn_mfma_f32_16x16x32_bf16(BUF[i_], bw, acc2, 0, 0, 0); else acc = __builtin_amdgcn_mfma_f32_16x16x32_bf16(BUF[i_], bw, acc, 0, 0, 0); } } while (0)
          R_LOAD(fa, 0); R_LOAD(fb, 1); R_PROC(fa, 0); R_LOAD(fa, 2); R_PROC(fb, 1); R_LOAD(fb, 3); R_PROC(fa, 2); R_PROC(fb, 3);
#undef R_LOAD
#undef R_PROC
        }
        acc = acc + acc2;
        f32x4 av;
#pragma unroll
        for (int rgi = 0; rgi < 4; ++rgi) { float x = acc[rgi], mx = x;
            mx = row_max16(mx);
            const float e = __expf(x - mx); float sm = e;
            sm = row_sum16(sm);
            av[rgi] = e / sm; }
        const int b = row0 >> 11, s0 = row0 & (SEQ - 1);
        *(f32x4*)(aff + ((size_t)(b * 16 + fr)) * SEQ + s0 + 4 * fq) = av;
    }
    __syncthreads();
}

__device__ __forceinline__ void phase_topk(const Params& p, LAS unsigned char* lds) {
    const float* aff = (const float*)(p.ws + WS_AFF); int* gidx = (int*)(p.ws + WS_IDX); float* gatev = (float*)(p.ws + WS_GATEV); int* slot_of = (int*)(p.ws + WS_SLOT);
    LAS unsigned* hist = (LAS unsigned*)lds; LAS unsigned* wsum = hist + 256; LAS unsigned* misc = wsum + 16;
    const int tid = threadIdx.x, lane = tid & 63, wave = tid >> 6;
    for (int job = blockIdx.x; job < 256; job += gridDim.x) {
        const u32x4 vv = *(const u32x4*)(aff + (size_t)job * SEQ + tid * 4);
        const unsigned v[4] = {vv.x, vv.y, vv.z, vv.w};
        __syncthreads();
        if (tid == 0) { misc[0] = 0u; misc[1] = 256u; }
        for (int pass = 3; pass >= 0; --pass) {
            const int shift = pass * 8;
            if (tid < 256) hist[tid] = 0u;
            __syncthreads();
            const unsigned prefix = misc[0], kleft = misc[1];
            const unsigned mask_hi = pass == 3 ? 0u : (0xFFFFFFFFu << (shift + 8));
#pragma unroll
            for (int j = 0; j < 4; ++j) if ((v[j] & mask_hi) == prefix) atomicAdd((unsigned*)&hist[(v[j] >> shift) & 255u], 1u);
            __syncthreads();
            unsigned cnt = 0u, x = 0u;
            if (tid < 256) { cnt = hist[tid]; x = cnt;
#pragma unroll
                for (int o = 1; o < 64; o <<= 1) { const unsigned t = __shfl_down(x, o); if (lane + o < 64) x += t; }
                if (lane == 0) wsum[wave] = x; }
            __syncthreads();
            if (tid < 256) { unsigned above_waves = 0u; for (int w = wave + 1; w < 4; ++w) above_waves += wsum[w];
                const unsigned incl = x + above_waves, above = incl - cnt;
                if (above < kleft && kleft <= incl) { misc[0] = prefix | ((unsigned)tid << shift); misc[1] = kleft - above; } }
            __syncthreads();
        }
        const unsigned thr = misc[0], need_eq = misc[1];
        unsigned cg_ = 0u, ce_ = 0u;
#pragma unroll
        for (int j = 0; j < 4; ++j) { cg_ += v[j] > thr; ce_ += v[j] == thr; }
        unsigned val = cg_ | (ce_ << 16), incl = val;
#pragma unroll
        for (int o = 1; o < 64; o <<= 1) { const unsigned t = __shfl_up(incl, o); if (lane >= o) incl += t; }
        if (lane == 63) wsum[8 + wave] = incl;
        __syncthreads();
        unsigned base = incl - val; for (int w = 0; w < wave; ++w) base += wsum[8 + w];
        unsigned gt_before = base & 0xffffu, eq_before = base >> 16;
        const int b = job >> 4, e = job & 15;
#pragma unroll
        for (int j = 0; j < 4; ++j) { const int s = tid * 4 + j; const bool isgt = v[j] > thr, iseq = v[j] == thr;
            const bool sel = isgt || (iseq && eq_before < need_eq);
            const unsigned slot = gt_before + (eq_before < need_eq ? eq_before : need_eq);
            if (sel) { gidx[job * 256 + slot] = b * SEQ + s; gatev[job * 256 + slot] = __uint_as_float(v[j]); }
            slot_of[(size_t)(b * SEQ + s) * 16 + e] = sel ? (int)slot : -1;
            gt_before += isgt; eq_before += iseq; }
        __syncthreads();
    }
}

__device__ __forceinline__ void phase_final(float* y, unsigned char* ws_, const float* g2, const float* b2, int row_lo, int row_hi, int gw, int NGW, int lane_in) {
    int lane = lane_in; asm volatile("" : "+v"(lane));
    const bf16_t* x1b = (const bf16_t*)(ws_ + WS_RB); const bf16_t* pl = (const bf16_t*)(ws_ + WS_RE)  ; const unsigned char* tg = ws_ + WS_TG  ; const unsigned char* ymoe = ws_ + WS_RA  ; const int* slot_of = (const int*)(ws_ + WS_SLOT);
    const int r0 = row_lo + gw;
    if (r0 >= row_hi) return;
    u32x2 xw[8], pw[8]; unsigned tw[8]; int sv;
#pragma unroll
    for (int j = 0; j < 8; ++j) { xw[j] = __builtin_nontemporal_load((const u32x2*)(x1b + (size_t)r0 * DM + 4 * lane + 256 * j)); pw[j] = __builtin_nontemporal_load((const u32x2*)(pl + (size_t)r0 * DM + 4 * lane + 256 * j)); tw[j] = __builtin_nontemporal_load((const unsigned*)(tg + (size_t)r0 * DM + 4 * lane + 256 * j)); }
    sv = slot_of[(size_t)r0 * 16 + (lane & 15)];
    for (int row = r0; row < row_hi; row += NGW) {
        const int b = row >> 11;
        unsigned long long bm = __ballot(lane < 16 && sv >= 0); unsigned m = (unsigned)bm & 0xffffu;
        const int cnt = __builtin_popcount(m);
        unsigned ym[4][8];
#pragma unroll
        for (int k = 0; k < 4; ++k) { if (k < cnt) { const int e = __builtin_ctz(m); m &= m - 1u; const int sl = __builtin_amdgcn_readlane(sv, e);
                const unsigned char* yr2 = ymoe + ((size_t)(b * 16 + e) * CAP + sl) * DM;
#pragma unroll
                for (int j = 0; j < 8; ++j) ym[k][j] = __builtin_nontemporal_load((const unsigned*)(yr2 + 4 * lane + 256 * j)); } }
        const int rn = row + NGW < row_hi ? row + NGW : row;
        u32x2 xn[8], pn[8]; unsigned tn[8];
#pragma unroll
        for (int j = 0; j < 8; ++j) { xn[j] = __builtin_nontemporal_load((const u32x2*)(x1b + (size_t)rn * DM + 4 * lane + 256 * j)); pn[j] = __builtin_nontemporal_load((const u32x2*)(pl + (size_t)rn * DM + 4 * lane + 256 * j)); tn[j] = __builtin_nontemporal_load((const unsigned*)(tg + (size_t)rn * DM + 4 * lane + 256 * j)); }
        const int svn = slot_of[(size_t)rn * 16 + (lane & 15)];
        f32x4 v[8];
#pragma unroll
        for (int j = 0; j < 8; ++j) { v[j] = (f32x4){bf_lo(xw[j].x), bf_hi(xw[j].x), bf_lo(xw[j].y), bf_hi(xw[j].y)} * ALPHA;
            const auto tl_ = __builtin_amdgcn_cvt_pk_f32_fp8((int)tw[j], false), th_ = __builtin_amdgcn_cvt_pk_f32_fp8((int)tw[j], true);
            const f32x4 t4 = (f32x4){tl_[0], tl_[1], th_[0], th_[1]} * 0.125f, p4 = {bf_lo(pw[j].x), bf_hi(pw[j].x), bf_lo(pw[j].y), bf_hi(pw[j].y)};
            f32x4 e4; e4[0] = __builtin_amdgcn_exp2f(t4[0]); e4[1] = __builtin_amdgcn_exp2f(t4[1]); e4[2] = __builtin_amdgcn_exp2f(t4[2]); e4[3] = __builtin_amdgcn_exp2f(t4[3]);
            const f32x4 d4 = e4 + 1.0f; f32x4 s4; s4[0] = __builtin_amdgcn_rcpf(d4[0]); s4[1] = __builtin_amdgcn_rcpf(d4[1]); s4[2] = __builtin_amdgcn_rcpf(d4[2]); s4[3] = __builtin_amdgcn_rcpf(d4[3]);
            v[j] += s4 * p4; }
#pragma unroll
        for (int k = 0; k < 4; ++k) { if (k < cnt) {
#pragma unroll
                for (int j = 0; j < 8; ++j) { const auto lo_ = __builtin_amdgcn_cvt_pk_f32_fp8((int)ym[k][j], false), hi_ = __builtin_amdgcn_cvt_pk_f32_fp8((int)ym[k][j], true);
                    v[j][0] += lo_[0] * (1.0f / 64.0f); v[j][1] += lo_[1] * (1.0f / 64.0f); v[j][2] += hi_[0] * (1.0f / 64.0f); v[j][3] += hi_[1] * (1.0f / 64.0f); } } }
        while (m) { const int e = __builtin_ctz(m); m &= m - 1u; const int sl = __builtin_amdgcn_readlane(sv, e);
            const unsigned char* yr2 = ymoe + ((size_t)(b * 16 + e) * CAP + sl) * DM;
#pragma unroll
            for (int j = 0; j < 8; ++j) { const int w = *(const int*)(yr2 + 4 * lane + 256 * j); const auto lo_ = __builtin_amdgcn_cvt_pk_f32_fp8(w, false), hi_ = __builtin_amdgcn_cvt_pk_f32_fp8(w, true);
                v[j][0] += lo_[0] * (1.0f / 64.0f); v[j][1] += lo_[1] * (1.0f / 64.0f); v[j][2] += hi_[0] * (1.0f / 64.0f); v[j][3] += hi_[1] * (1.0f / 64.0f); } }
        float s = 0.f;
#pragma unroll
        for (int j = 0; j < 8; ++j) s += (v[j][0] + v[j][1]) + (v[j][2] + v[j][3]);
        const float mean = wave_sum(s) * (1.0f / DM); float s2 = 0.f;
#pragma unroll
        for (int j = 0; j < 8; ++j) { v[j] = v[j] - mean; s2 += (v[j][0] * v[j][0] + v[j][1] * v[j][1]) + (v[j][2] * v[j][2] + v[j][3] * v[j][3]); }
        const float rstd = rsqrtf(wave_sum(s2) * (1.0f / DM) + NORM_EPS);
        float* yr = y + (size_t)row * DM;
#pragma unroll
        for (int j = 0; j < 8; ++j) { const f32x4 gg = *(const f32x4*)(g2 + 4 * lane + 256 * j), bb = *(const f32x4*)(b2 + 4 * lane + 256 * j);
            __builtin_nontemporal_store(v[j] * rstd * gg + bb, (f32x4*)(yr + 4 * lane + 256 * j)); }
#pragma unroll
        for (int j = 0; j < 8; ++j) { xw[j] = xn[j]; pw[j] = pn[j]; tw[j] = tn[j]; }
        sv = svn;
    }
}

struct MoeOrderH {
    int G, c, half; float* fy; unsigned char* fws; const float* fg2; const float* fb2; int frow_lo, frow_hi;
    __device__ __forceinline__ bool next(int i, pg8::Unit& u) const {
        if (G == 256) { if (i >= 4) return false; const int x = c & 7, w = c >> 3, e = 4 * i + (x >> 1), b = half * 8 + 4 * (x & 1) + (w >> 3), j = w & 7; u.pm = b * 16 + e; u.pn = e * 8 + j; return true; }
        const long L = (long)i * G + c; if (L >= 1024) return false;
        const int pl_ = (int)(L >> 3), b = half * 8 + (pl_ >> 4), e = pl_ & 15; u.pm = b * 16 + e; u.pn = e * 8 + (int)(L & 7); return true;
    }
    __device__ __forceinline__ bool slot(int ui) const {
        if (frow_lo >= frow_hi) return false;
        if (ui != (G == 256 ? ((c >> 3) & 3) : 0)) return false;
        const int wv = __builtin_amdgcn_readfirstlane(threadIdx.x >> 6);
        phase_final(fy, fws, fg2, fb2, frow_lo, frow_hi, c * 8 + wv, G * 8, threadIdx.x & 63);
        return true;
    }
};

#define XB_TMO      128
#define XB_XCNT(j)  (256  + 64 * (j))
#define XB_XSUB(j)  (1280 + 64 * (j))
#define XB_XGEN(j)  (2304 + 64 * (j))
#define XB_TOP      3328
#define XB_TOPGEN   3392
#define XCD_BAR_WORDS 3456
#define XB_SPIN_CAP (1u << 18)
__device__ __forceinline__ unsigned xb_ld(unsigned* p)              { return __hip_atomic_load(p, __ATOMIC_RELAXED, __HIP_MEMORY_SCOPE_AGENT); }
__device__ __forceinline__ unsigned xb_add(unsigned* p, unsigned v) { return __hip_atomic_fetch_add(p, v, __ATOMIC_RELAXED, __HIP_MEMORY_SCOPE_AGENT); }
__device__ __forceinline__ unsigned xb_xcc_id() { return (unsigned)__builtin_amdgcn_s_getreg((3 << 11) | 20) & 0xFu; }
#define XB_SPIN(cond, bar) do { unsigned _sp = 0; while (cond) { __builtin_amdgcn_s_sleep(1); \
    if ((++_sp & 255u) == 0u) { if (xb_ld(&(bar)[XB_TMO])) break; if (_sp > XB_SPIN_CAP) { atomicAdd(&(bar)[XB_TMO], 1u); break; } } } } while (0)
struct XcdBarrier { unsigned* bar; unsigned x; volatile LAS unsigned* st; };
__device__ __forceinline__ XcdBarrier xcd_barrier_post(unsigned* bar, volatile LAS unsigned* st) {
    XcdBarrier b; b.bar = bar; b.x = xb_xcc_id(); b.st = st;
    if (threadIdx.x == 0) (void)xb_add(&bar[XB_XCNT(b.x)], 1u);
    return b;
}
__device__ __forceinline__ void xcd_barrier_complete(unsigned* bar, unsigned x, unsigned& nloc, unsigned& nx) {
    const unsigned G = gridDim.x * gridDim.y * gridDim.z;
    unsigned sum, cnt, mine, sp = 0u;
    for (;;) {
        sum = 0u; cnt = 0u; mine = 0u;
#pragma unroll
        for (unsigned j = 0; j < 16; ++j) { const unsigned c = xb_ld(&bar[XB_XCNT(j)]); sum += c; cnt += (c > 0u) ? 1u : 0u; mine = (j == x) ? c : mine; }
        if (sum == G) break;
        __builtin_amdgcn_s_sleep(1);
        if ((++sp & 255u) == 0u) { if (xb_ld(&bar[XB_TMO])) break; if (sp > XB_SPIN_CAP) { atomicAdd(&bar[XB_TMO], 1u); break; } }
    }
    nloc = mine > 0u ? mine : 1u; nx = cnt > 0u ? cnt : 1u;
}
__device__ __forceinline__ void xcd_barrier(const XcdBarrier& b) {
    asm volatile("s_waitcnt vmcnt(0)" ::: "memory");
    __syncthreads();
    if (threadIdx.x == 0) {
        unsigned* bar = b.bar;
        __builtin_amdgcn_s_waitcnt(0);
        unsigned nloc = b.st[0], nx = b.st[1];
        if (nloc == 0u) { xcd_barrier_complete(bar, b.x, nloc, nx); b.st[0] = nloc; b.st[1] = nx; }
        const unsigned old = xb_add(&bar[XB_XSUB(b.x)], 1u);
        const unsigned gen = old / nloc;
        if (old + 1u == (gen + 1u) * nloc) {
            __builtin_amdgcn_fence(__ATOMIC_RELEASE, "agent");
            asm volatile("s_waitcnt vmcnt(0)" ::: "memory");
            const unsigned og = xb_add(&bar[XB_TOP], 1u);
            const unsigned tg = og / nx;
            if (og + 1u == (tg + 1u) * nx) xb_add(&bar[XB_TOPGEN], 1u);
            else XB_SPIN(xb_ld(&bar[XB_TOPGEN]) == tg, bar);
            __builtin_amdgcn_fence(__ATOMIC_ACQUIRE, "agent");
            xb_add(&bar[XB_XGEN(b.x)], 1u);
            asm volatile("s_waitcnt vmcnt(0)" ::: "memory");
        } else {
            XB_SPIN(xb_ld(&bar[XB_XGEN(b.x)]) == gen, bar);
            __builtin_amdgcn_fence(__ATOMIC_ACQUIRE, "agent");
            asm volatile("s_waitcnt vmcnt(0)" ::: "memory");
        }
    }
    __syncthreads();
}

__global__ void __launch_bounds__(512, 2) mk_fwd(Params parg) {
#if defined(__HIP_DEVICE_COMPILE__)
#define LOADP() const __attribute__((address_space(4))) Params* pk_ = (const __attribute__((address_space(4))) Params*)__builtin_amdgcn_kernarg_segment_ptr(); asm volatile("" : "+s"(pk_)); const Params p = *pk_; \
    int tl_ = threadIdx.x; asm volatile("" : "+v"(tl_)); const int lane = tl_ & 63
#else
#define LOADP() const Params p = parg; const int lane = threadIdx.x & 63
#endif
    extern __shared__ __attribute__((aligned(16))) unsigned char lds_raw[];
    LAS unsigned char* lds = (LAS unsigned char*)lds_raw;
    const int tid = threadIdx.x, wave = __builtin_amdgcn_readfirstlane(tid >> 6);
    const int G = gridDim.x, c = blockIdx.x;
    const int gw = c * 8 + wave, NGW = G * 8;
    unsigned char* ws = parg.ws;
    const int lo = parg.ph_lo, hi = parg.ph_hi;
#ifndef MK_MASK
#define MK_MASK 0x7ff
#endif
#define IN(k) (((MK_MASK >> (k)) & 1) && lo <= (k) && (k) < hi)
#if MK_ONE_LAUNCH
    volatile LAS unsigned* bst = (volatile LAS unsigned*)(lds + LDS_MISC);
    if (tid < 2) bst[tid] = 0u;
    __syncthreads();
    (void)xcd_barrier_post((unsigned*)(ws + WS_CTL) + 4096, bst);
#define xbar (XcdBarrier{(unsigned*)(ws + WS_CTL) + 4096, xb_xcc_id(), (volatile LAS unsigned*)(lds + LDS_MISC)})
#define SEAM(k) do { if (IN(k) && IN((k) + 1)) xcd_barrier(xbar); } while (0)
#else
#define SEAM(k) do { } while (0)
#endif
    if (IN(0)) { LOADP(); phase0(p, lds, gw, NGW, wave, lane); }
    SEAM(0);
    if (IN(1)) { LOADP();
        { pg8::StaticOrderOff S; S.init(NTOK, 2048, G, c); S.off = 6;
          pg8::EpiProj E{(bf16_t*)(ws + WS_RA), (float*)(ws + WS_GATES)};
          pg8::gemm_phase<pg8::EpiProj, pg8::StaticOrderOff, false>(lds, (const bf16_t*)(ws + WS_RB), (const bf16_t*)(ws + WS_WIN), 2048, S, E, nullptr); }
        { pg8::StaticOrder S; S.init(NTOK, 2560, G, c);
          pg8::EpiProj8 E{(bf16_t*)(ws + WS_RA)};
          pg8::gemm_phase<pg8::EpiProj8, pg8::StaticOrder, false, true>(lds, ws + WS_RC, ws + WS_WIN8, 2048, S, E, nullptr); } }
    SEAM(1);
    if (IN(2)) { LOADP(); phase_normrope(p, gw, NGW, lane); phase_convsilu(p, gw, NGW, lane); }
    SEAM(2);
    if (IN(3)) { LOADP();
#ifdef MK_MLSTM_NAIVE
        phase_mlstm_naive(p, lds);
#else
        phase_mlstm(p, lds);
#endif
    }
    SEAM(3);
    if (IN(4)) { LOADP(); phase_attention(p, lds_raw); }
    SEAM(4);
    if (IN(5)) { LOADP(); pg8::StaticOrderRevM S; S.init(NTOK, DM, G, c); pg8::EpiOut E{(const bf16_t*)(ws + WS_RB), (bf16_t*)p.out};
        pg8::gemm_phase_mix<pg8::EpiOut, pg8::StaticOrderRevM>(lds, ws + WS_RE, ws + WS_WOUT8, 1024, 8, ws + WS_RC, ws + WS_WOUT, 4096, 16, 1.0f / 512.0f, S, E); }
    SEAM(5);
    if (IN(6)) { LOADP(); phase_ln1_router(p, lds, gw, NGW, lane); }
    SEAM(6);
    if (IN(7)) { LOADP(); phase_topk(p, lds); }
    SEAM(7);
    if (IN(8)) { LOADP();
        { pg8::StaticOrder S; S.init(NTOK, DM, G, c); pg8::EpiPlGate E{ws + WS_TG, p.in[I_BPG]};
          pg8::gemm_phase<pg8::EpiPlGate, pg8::StaticOrder, false, true>(lds, ws + WS_RA, ws + WS_WPG, 2048, S, E, nullptr); }
        { pg8::MoeOrder S{G, c}; pg8::EpiGU E{ws + WS_RC};
          pg8::gemm_phase<pg8::EpiGU, pg8::MoeOrder, true, true>(lds, ws + WS_RA, ws + WS_WGU, 2048, S, E, (const int*)(ws + WS_IDX)); }
    }
    SEAM(8);
    if (IN(9)) { LOADP();
        pg8::MoeOrderRev S{{G, c}}; pg8::EpiDown E{ws + WS_RA, (const float*)(ws + WS_GATEV)};
        pg8::gemm_phase<pg8::EpiDown, pg8::MoeOrderRev, false, true>(lds, ws + WS_RC, ws + WS_WDN, 1024, S, E, nullptr);
        { pg8::StaticOrder S; S.init(NTOK, DM, G, c); pg8::EpiPlain E{(bf16_t*)(ws + WS_RE)};
          pg8::gemm_phase<pg8::EpiPlain, pg8::StaticOrder, false>(lds, (const bf16_t*)(ws + WS_PB), (const bf16_t*)(ws + WS_WPP), 256, S, E, nullptr); }
    }
    SEAM(9);
    if (IN(10)) { LOADP(); phase_final(p.out, ws, p.in[I_LN2G], p.in[I_LN2B], 0, NTOK, gw, NGW, lane); }
#undef IN
#undef SEAM
}

extern "C" void kernel_launch(void* const* d_in, const int* in_sizes, int n_in, void* d_out, int out_size, void* d_ws, size_t ws_size, hipStream_t stream) {
    static int grid = 0;
    if (grid == 0) {
        if (n_in != 21 || in_sizes[0] != NTOK * DM || out_size != NTOK * DM || ws_size < WS_END) {
            fprintf(stderr, "kernel_launch: shape mismatch: n_in %d in0 %d out %d ws %zu (need >= %zu)\n", n_in, n_in > 0 ? in_sizes[0] : -1, out_size, ws_size, (size_t)WS_END); grid = -1; return; }
        int dev = 0, cus = 0, per_cu = 0;
        if (hipGetDevice(&dev) != hipSuccess || hipDeviceGetAttribute(&cus, hipDeviceAttributeMultiprocessorCount, dev) != hipSuccess) { fprintf(stderr, "kernel_launch: device query failed\n"); grid = -1; return; }
        if (hipFuncSetAttribute((const void*)mk_fwd, hipFuncAttributeMaxDynamicSharedMemorySize, LDS_BYTES) != hipSuccess) { fprintf(stderr, "kernel_launch: hipFuncSetAttribute failed\n"); grid = -1; return; }
        if (hipOccupancyMaxActiveBlocksPerMultiprocessor(&per_cu, (const void*)mk_fwd, 512, LDS_BYTES) != hipSuccess || per_cu < 1) { fprintf(stderr, "kernel_launch: occupancy query says %d blocks per CU\n", per_cu); (void)hipGetLastError(); per_cu = 1; }
        grid = cus;
    }
    if (grid < 0) return;
    if (hipMemsetAsync((char*)d_ws + WS_CTL, 0, 65536, stream) != hipSuccess) { fprintf(stderr, "kernel_launch: memset of control words failed\n"); return; }
    Params p{};
    for (int i = 0; i < 21; ++i) p.in[i] = (const float*)d_in[i];
    p.out = (float*)d_out; p.ws = (unsigned char*)d_ws;
#if MK_ONE_LAUNCH
    p.ph_lo = 0; p.ph_hi = 11;
    void* args[] = {&p};
    hipError_t e = hipLaunchCooperativeKernel((const void*)mk_fwd, dim3(grid), dim3(512), args, LDS_BYTES, stream);
    if (e != hipSuccess) fprintf(stderr, "kernel_launch: cooperative launch failed: %s (grid %d)\n", hipGetErrorString(e), grid);
#else
#ifndef MK_SEQ
#define MK_SEQ 0,1,2,3,4,5,6,7,8,9,10
#endif
    static const int seq_[] = {MK_SEQ};
    for (int si = 0; si < (int)(sizeof(seq_) / sizeof(seq_[0])); ++si) {
        p.ph_lo = seq_[si]; p.ph_hi = seq_[si] + 1;
        hipLaunchKernelGGL(mk_fwd, dim3(grid), dim3(512), LDS_BYTES, stream, p);
    }
    const hipError_t le = hipPeekAtLastError();
    if (le != hipSuccess) fprintf(stderr, "kernel_launch: launch failed: %s\n", hipGetErrorName(le));
#endif
}
```
